# Optimizing an MI355X kernel written in HIP

```python
import math
import jax, jax.numpy as jnp
from jax import lax
import numpy as np

D_MODEL = 1024
BATCH = 32
SEQ = 2048
DEPTH = 1

RET_HEADS = 4
RET_QK_DIM = 128
RET_V_DIM = 256
RET_CHUNK = 128
RET_QK_W = RET_HEADS * RET_QK_DIM
RET_V_W = RET_HEADS * RET_V_DIM
NA_HEADS = 8
NA_HEAD_DIM = 64
NA_W = NA_HEADS * NA_HEAD_DIM
GRID_W = 64
NA_WIN_ROWS = 8
NA_WIN_COLS = 16
NA_Q_BLOCK_COLS = 16
NA_K_BLOCK_COLS = 32
NA_REL_ROWS = 2 * NA_WIN_ROWS - 1
NA_REL_COLS = 2 * NA_WIN_COLS - 1
D_FF = 2816
RMS_EPS = 1e-6
ROPE_BASE = 10000.0
NEG_INF = -1e30
MIX_SPLITS = (RET_QK_W, RET_QK_W, RET_V_W, RET_V_W, NA_W, NA_W, NA_W, D_MODEL, D_MODEL)
MIX_IN_W = sum(MIX_SPLITS)

kernel_name = "hybrid_retention_natten_macaron_block"


def _rms_norm(x, gain):
    xf = x.astype(jnp.float32)
    y = xf * lax.rsqrt(jnp.mean(xf * xf, axis=-1, keepdims=True) + RMS_EPS)
    return (y * gain.astype(jnp.float32)).astype(x.dtype)


def _swiglu(x, w_in, w_out):
    g, u = jnp.split(x @ w_in, 2, axis=-1)
    return (jax.nn.silu(g) * u) @ w_out


def _rotary(x, pos):
    half = x.shape[-1] // 2
    inv = 1.0 / (ROPE_BASE ** jnp.linspace(0.0, 1.0, half, dtype=jnp.float32))
    ang = pos[:, None] * inv[None, :]
    cos, sin = jnp.cos(ang), jnp.sin(ang)
    x1, x2 = x[..., :half], x[..., half:]
    return jnp.concatenate([x1 * cos - x2 * sin, x1 * sin + x2 * cos], axis=-1)


def _retention_one_dir(q, k, v, log_gamma, strict):
    B, H, S, DK = q.shape
    DV = v.shape[-1]
    C = RET_CHUNK
    N = S // C
    qc = q.reshape(B, H, N, C, DK)
    kc = k.reshape(B, H, N, C, DK)
    vc = v.reshape(B, H, N, C, DV)
    idx = jnp.arange(C, dtype=jnp.float32)
    diff = idx[:, None] - idx[None, :]
    lower = (diff > 0) if strict else (diff >= 0)
    intra = jnp.where(lower[None], jnp.exp(log_gamma[:, None, None] * jnp.where(lower, diff, 0.0)[None]), 0.0)
    scores = jnp.einsum('bhnqd,bhnkd->bhnqk', qc, kc) * intra[None, :, None]
    inner = jnp.einsum('bhnqk,bhnkv->bhnqv', scores, vc)
    k_dec = jnp.exp(log_gamma[:, None] * (C - 1 - idx)[None, :])
    upd = jnp.einsum('bhnkd,bhnkv->nbhdv', kc * k_dec[None, :, None, :, None], vc)
    chunk_dec = jnp.exp(log_gamma * C)[None, :, None, None]

    def step(state, u):
        return chunk_dec * state + u, state

    _, prev = lax.scan(step, jnp.zeros((B, H, DK, DV), jnp.float32), upd)
    q_dec = jnp.exp(log_gamma[:, None] * (idx + 1.0)[None, :])
    cross = jnp.einsum('bhnqd,nbhdv->bhnqv', qc * q_dec[None, :, None, :, None], prev)
    return (inner + cross).reshape(B, H, S, DV)


def _bidirectional_retention(q, k, v, decay_fwd_logit, decay_bwd_logit):
    lg_f = jax.nn.log_sigmoid(decay_fwd_logit.astype(jnp.float32))
    lg_b = jax.nn.log_sigmoid(decay_bwd_logit.astype(jnp.float32))
    y_f = _retention_one_dir(q, k, v, lg_f, strict=False)
    flip = lambda a: jnp.flip(a, axis=2)
    y_b = flip(_retention_one_dir(flip(q), flip(k), flip(v), lg_b, strict=True))
    return y_f + y_b


def _neighborhood_attention(q, k, v, rel_bias):
    B, S, NH, DH = q.shape
    rows = S // GRID_W
    kr = min(NA_WIN_ROWS, rows)
    ncb = GRID_W // NA_Q_BLOCK_COLS
    qg = (q * (DH ** -0.5)).reshape(B, rows, GRID_W, NH, DH)
    kg = k.reshape(B, rows, GRID_W, NH, DH)
    vg = v.reshape(B, rows, GRID_W, NH, DH)
    c0 = jnp.arange(ncb, dtype=jnp.int32) * NA_Q_BLOCK_COLS
    q_cols = c0[:, None] + jnp.arange(NA_Q_BLOCK_COLS, dtype=jnp.int32)[None, :]
    key_cols = (jnp.clip(c0 - NA_WIN_COLS // 2, 0, GRID_W - NA_K_BLOCK_COLS)[:, None]
                + jnp.arange(NA_K_BLOCK_COLS, dtype=jnp.int32)[None, :])
    win_start = jnp.clip(q_cols - NA_WIN_COLS // 2, 0, GRID_W - NA_WIN_COLS)
    kcb = key_cols[:, None, :]
    col_mask = (kcb >= win_start[:, :, None]) & (kcb < win_start[:, :, None] + NA_WIN_COLS)
    col_idx = jnp.clip(kcb - q_cols[:, :, None] + NA_WIN_COLS - 1, 0, NA_REL_COLS - 1)

    def row_block(r):
        rs = jnp.clip(r - kr // 2, 0, rows - kr)
        q_r = lax.dynamic_index_in_dim(qg, r, axis=1, keepdims=False).reshape(B, ncb, NA_Q_BLOCK_COLS, NH, DH)
        k_blk = lax.dynamic_slice_in_dim(kg, rs, kr, axis=1)[:, :, key_cols]
        v_blk = lax.dynamic_slice_in_dim(vg, rs, kr, axis=1)[:, :, key_cols]
        s = jnp.einsum('bnqhd,brnkhd->bhnqrk', q_r, k_blk).astype(jnp.float32)
        row_idx = rs + jnp.arange(kr, dtype=jnp.int32) - r + NA_WIN_ROWS - 1
        bias = rel_bias[:, row_idx[None, None, :, None], col_idx[:, :, None, :]].astype(jnp.float32)
        s = jnp.where(col_mask[:, :, None, :], s + bias, NEG_INF)
        p = jax.nn.softmax(s.reshape(B, NH, ncb, NA_Q_BLOCK_COLS, kr * NA_K_BLOCK_COLS), axis=-1)
        p = p.reshape(s.shape).astype(v.dtype)
        o = jnp.einsum('bhnqrk,brnkhd->bnqhd', p, v_blk)
        return o.reshape(B, GRID_W, NH, DH)

    out = lax.map(row_block, jnp.arange(rows, dtype=jnp.int32))
    return out.transpose(1, 0, 2, 3, 4).reshape(B, S, NH * DH)


def _token_mixing(u, w_in, decay_fwd, decay_bwd, rel_bias, w_ret_out, w_na_out, w_out, pos):
    B, S, _ = u.shape
    points = [sum(MIX_SPLITS[:i + 1]) for i in range(len(MIX_SPLITS) - 1)]
    rq, rk, rv, rg, nq, nk, nv, g_ret, g_na = jnp.split(u @ w_in, points, axis=-1)
    heads = lambda a, d: a.reshape(B, S, RET_HEADS, d).transpose(0, 2, 1, 3).astype(jnp.float32)
    q = _rotary(heads(rq, RET_QK_DIM), pos)
    k = _rotary(heads(rk, RET_QK_DIM), pos) * (RET_QK_DIM ** -0.5)
    y = _bidirectional_retention(q, k, heads(rv, RET_V_DIM), decay_fwd, decay_bwd)
    y = y * lax.rsqrt(jnp.mean(y * y, axis=-1, keepdims=True) + RMS_EPS)
    y = y.transpose(0, 2, 1, 3).reshape(B, S, RET_V_W).astype(u.dtype)
    y_ret = (jax.nn.silu(rg) * y) @ w_ret_out
    na_heads = lambda a: a.reshape(B, S, NA_HEADS, NA_HEAD_DIM)
    y_na = _neighborhood_attention(na_heads(nq), na_heads(nk), na_heads(nv), rel_bias) @ w_na_out
    merged = jax.nn.sigmoid(g_ret) * y_ret + jax.nn.sigmoid(g_na) * y_na
    return merged @ w_out


def setup_inputs(seed: int = 0) -> dict:
    key = jax.random.key(seed)
    ks = jax.random.split(key, 20)
    f32 = jnp.float32

    def w(k, shape, fan_in):
        return jax.random.normal(k, (DEPTH,) + shape, f32) * (fan_in ** -0.5)

    def gain(k):
        return 1.0 + 0.05 * jax.random.normal(k, (DEPTH, D_MODEL), f32)

    gamma0 = 1.0 - 2.0 ** (-5.0 - np.arange(RET_HEADS, dtype=np.float32))
    logit0 = jnp.asarray(np.log(gamma0 / (1.0 - gamma0)), f32)
    return {
        "x": jax.random.normal(ks[0], (BATCH, SEQ, D_MODEL), f32),
        "ffn1_pre_norm": gain(ks[1]),
        "ffn1_w_in": w(ks[2], (D_MODEL, 2 * D_FF), D_MODEL),
        "ffn1_w_out": w(ks[3], (D_FF, D_MODEL), D_FF),
        "ffn1_post_norm": gain(ks[4]),
        "mix_pre_norm": gain(ks[5]),
        "w_mix_in": w(ks[6], (D_MODEL, MIX_IN_W), D_MODEL),
        "ret_decay_fwd": logit0[None] + 0.1 * jax.random.normal(ks[7], (DEPTH, RET_HEADS), f32),
        "ret_decay_bwd": logit0[None] + 0.1 * jax.random.normal(ks[8], (DEPTH, RET_HEADS), f32),
        "na_rel_bias": 0.02 * jax.random.normal(ks[9], (DEPTH, NA_HEADS, NA_REL_ROWS, NA_REL_COLS), f32),
        "w_ret_out": w(ks[10], (RET_V_W, D_MODEL), RET_V_W),
        "w_na_out": w(ks[11], (NA_W, D_MODEL), NA_W),
        "w_mix_out": w(ks[12], (D_MODEL, D_MODEL), D_MODEL),
        "mix_post_norm": gain(ks[13]),
        "ffn2_pre_norm": gain(ks[14]),
        "ffn2_w_in": w(ks[15], (D_MODEL, 2 * D_FF), D_MODEL),
        "ffn2_w_out": w(ks[16], (D_FF, D_MODEL), D_FF),
        "ffn2_post_norm": gain(ks[17]),
    }


def reference(x, ffn1_pre_norm, ffn1_w_in, ffn1_w_out, ffn1_post_norm, mix_pre_norm, w_mix_in,
              ret_decay_fwd, ret_decay_bwd, na_rel_bias, w_ret_out, w_na_out, w_mix_out, mix_post_norm,
              ffn2_pre_norm, ffn2_w_in, ffn2_w_out, ffn2_post_norm):
    S = x.shape[1]
    pos = jnp.arange(S, dtype=jnp.float32)
    for l in range(DEPTH):
        h = _swiglu(_rms_norm(x, ffn1_pre_norm[l]), ffn1_w_in[l], ffn1_w_out[l])
        x = x + 0.5 * _rms_norm(h, ffn1_post_norm[l])
        m = _token_mixing(_rms_norm(x, mix_pre_norm[l]), w_mix_in[l], ret_decay_fwd[l], ret_decay_bwd[l],
                          na_rel_bias[l], w_ret_out[l], w_na_out[l], w_mix_out[l], pos)
        x = x + _rms_norm(m, mix_post_norm[l])
        h = _swiglu(_rms_norm(x, ffn2_pre_norm[l]), ffn2_w_in[l], ffn2_w_out[l])
        x = x + 0.5 * _rms_norm(h, ffn2_post_norm[l])
    return x
```

```cpp
#include <hip/hip_runtime.h>
#include <hip/hip_cooperative_groups.h>
#include <cstdio>
#include <cstdint>
namespace cg = cooperative_groups;
__device__ __forceinline__ float shx(float v, int mask) {
    int l; asm volatile("v_mbcnt_lo_u32_b32 %0, -1, 0\n\tv_mbcnt_hi_u32_b32 %0, -1, %0" : "=v"(l));
    return __builtin_bit_cast(float, __builtin_amdgcn_ds_bpermute((l ^ mask) << 2, __builtin_bit_cast(int, v)));
}
namespace pg8 {
#define PG8_LAS __attribute__((address_space(3)))
typedef unsigned short bf16_t;
typedef short bf16x8 __attribute__((ext_vector_type(8)));
typedef float f32x4 __attribute__((ext_vector_type(4)));
typedef unsigned u32x4 __attribute__((ext_vector_type(4)));
constexpr int BM = 256, BK = 64, HALF = 128, HTB = HALF * BK * 2  , STAGE_BYTES = 8 * HTB, NXCD = 8, WGM = 8;

__host__ __device__ __forceinline__ int lds_byte(int r, int c) { const int st = (r >> 4) * 2 + (c >> 5), rr = r & 15, cc = c & 31, ob = rr * 64 + cc * 2; return st * 1024 + (ob ^ (((ob >> 9) & 1) << 5)); }
__host__ __device__ __forceinline__ void stage_rc(int b, int& R, int& C) { const int st = b / 1024, sb = b % 1024, swz = sb ^ (((sb >> 9) & 1) << 5); R = (st >> 1) * 16 + swz / 64; C = (st & 1) * 32 + (swz % 64) / 2; }
__host__ __device__ __forceinline__ int perm32(int rho) { const int n = rho >> 4, i = rho & 15; return 8 * (i >> 2) + 4 * n + (i & 3); }

struct Unit { int pm, pn; };
struct Gemm { const bf16_t* A; const bf16_t* Bt; int lda, ldb, M, N, K; };

struct StaticOrder {
    int nM, nN, nwg, G, c, rev;
    __host__ __device__ void init(int M, int N, int G_, int c_) { nM = M / BM; nN = N / BM; nwg = nM * nN; G = G_; c = c_; rev = 0; }
    __host__ __device__ bool next(int i, Unit& u) const {
        const long L = (long)i * G + c; if (L >= nwg) return false;
        int wgid = (int)L; { const int q = nwg / NXCD, r = nwg % NXCD, xcd = wgid % NXCD, off = wgid / NXCD; wgid = (xcd < r ? xcd * (q + 1) : r * (q + 1) + (xcd - r) * q) + off; }
        const int nig = WGM * nN, gid = wgid / nig, fm = gid * WGM, gsz = (nM - fm) < WGM ? (nM - fm) : WGM;
        u.pm = fm + ((wgid % nig) % gsz); u.pn = (wgid % nig) / gsz; if (rev) u.pm = nM - 1 - u.pm; return true;
    }
    __device__ __forceinline__ void a_ready(const Unit&) const {}
    __device__ __forceinline__ void done(const Unit&) const {}
};


typedef float f32x2_t __attribute__((ext_vector_type(2)));
typedef __bf16 bf16x2_t __attribute__((ext_vector_type(2)));
__device__ __forceinline__ unsigned cvtpk(float lo, float hi) { f32x2_t v = {lo, hi}; bf16x2_t b = __builtin_convertvector(v, bf16x2_t); return __builtin_bit_cast(unsigned, b); }
__device__ __forceinline__ float bf_lo(unsigned w) { return __uint_as_float(w << 16); }
__device__ __forceinline__ float bf_hi(unsigned w) { return __uint_as_float(w & 0xffff0000u); }
__device__ __forceinline__ float sigm_f(float v) { return __builtin_amdgcn_rcpf(1.0f + __builtin_amdgcn_exp2f(-1.44269504f * v)); }
__device__ __forceinline__ float silu_f(float v) { return v * sigm_f(v); }
__device__ __forceinline__ void store8(bf16_t* p, const f32x4 a, const f32x4 b) {
    u32x4 w; w.x = cvtpk(a[0], a[1]); w.y = cvtpk(a[2], a[3]); w.z = cvtpk(b[0], b[1]); w.w = cvtpk(b[2], b[3]); *(u32x4*)p = w;
}
typedef unsigned u32x2 __attribute__((ext_vector_type(2)));
enum EpiMode { M_STORE = 0, M_SWIGLU = 1, M_MIX = 2, M_VT = 3, M_RETOUT = 4, M_NAOUT = 5 };
struct Epi {
    static constexpr bool PERM = true, AFTER_DRAIN = false;
    int mode; bf16_t* O; int ldc; const float* rs; const float* cs; const float* sn; const bf16_t* gate; int ldg;
    __device__ __forceinline__ void operator()(const f32x4 (&acc)[2][2][4][2], const Unit& u, int wr, int wc, int fr, int fq) const {
        const int row0 = u.pm * BM + wr * 64 + fr;
        const int cw = wc * 32 + 8 * fq;
        if (mode == M_STORE) {
#pragma unroll
            for (int ai = 0; ai < 2; ++ai)
#pragma unroll
                for (int m = 0; m < 4; ++m) { bf16_t* rowp = O + (size_t)(row0 + ai * HALF + m * 16) * ldc + u.pn * BM + cw;
#pragma unroll
                    for (int bj = 0; bj < 2; ++bj) store8(rowp + bj * HALF, acc[ai][bj][m][0], acc[ai][bj][m][1]); }
        } else if (mode == M_SWIGLU) {
#pragma unroll
            for (int ai = 0; ai < 2; ++ai)
#pragma unroll
                for (int m = 0; m < 4; ++m) { const int row = row0 + ai * HALF + m * 16; const float rsv = __builtin_amdgcn_rsqf(rs[row] * (1.0f / 1024.0f) + 1e-6f);
                    f32x4 h0, h1;
#pragma unroll
                    for (int e = 0; e < 4; ++e) { h0[e] = silu_f(acc[ai][0][m][0][e] * rsv) * (acc[ai][1][m][0][e] * rsv); h1[e] = silu_f(acc[ai][0][m][1][e] * rsv) * (acc[ai][1][m][1][e] * rsv); }
                    store8(O + (size_t)row * ldc + u.pn * HALF + cw, h0, h1); }
        } else if (mode == M_MIX) {
            const int sub = u.pn < 4 ? 0 : (u.pn < 8 ? 1 : (u.pn < 12 ? 2 : 3));
            if (sub == 0) {
                const int i0 = 32 * (wc & 1) + 8 * fq;
#pragma unroll
                for (int ai = 0; ai < 2; ++ai)
#pragma unroll
                    for (int m = 0; m < 4; ++m) { const int row = row0 + ai * HALF + m * 16; const float rsv = __builtin_amdgcn_rsqf(rs[row] * (1.0f / 1024.0f) + 1e-6f); const int pos = row & 2047;
                        const f32x4 c0 = *(const f32x4*)(cs + pos * 64 + i0), c1 = *(const f32x4*)(cs + pos * 64 + i0 + 4);
                        const f32x4 s0 = *(const f32x4*)(sn + pos * 64 + i0), s1 = *(const f32x4*)(sn + pos * 64 + i0 + 4);
                        const f32x4 x1a = acc[ai][0][m][0] * rsv, x1b = acc[ai][0][m][1] * rsv, x2a = acc[ai][1][m][0] * rsv, x2b = acc[ai][1][m][1] * rsv;
                        bf16_t* rowp = O + (size_t)row * ldc + u.pn * BM + cw;
                        store8(rowp, x1a * c0 - x2a * s0, x1b * c1 - x2b * s1);
                        store8(rowp + HALF, x1a * s0 + x2a * c0, x1b * s1 + x2b * c1); }
            } else {
#pragma unroll
                for (int ai = 0; ai < 2; ++ai)
#pragma unroll
                    for (int m = 0; m < 4; ++m) { const int row = row0 + ai * HALF + m * 16; const float rsv = __builtin_amdgcn_rsqf(rs[row] * (1.0f / 1024.0f) + 1e-6f);
                        bf16_t* rowp = O + (size_t)row * ldc + u.pn * BM + cw;
#pragma unroll
                        for (int bj = 0; bj < 2; ++bj) { f32x4 v0 = acc[ai][bj][m][0] * rsv, v1 = acc[ai][bj][m][1] * rsv;
                            if (sub == 1) {
#pragma unroll
                                for (int e = 0; e < 4; ++e) { v0[e] = silu_f(v0[e]); v1[e] = silu_f(v1[e]); } }
                            else if (sub == 3) {
#pragma unroll
                                for (int e = 0; e < 4; ++e) { v0[e] = sigm_f(v0[e]); v1[e] = sigm_f(v1[e]); } }
                            store8(rowp + bj * HALF, v0, v1); } }
            }
        } else if (mode == M_VT) {
            f32x4 cv[2][2];
#pragma unroll
            for (int bj = 0; bj < 2; ++bj)
#pragma unroll
                for (int n = 0; n < 2; ++n) { const f32x4 sv = *(const f32x4*)(rs + u.pn * BM + bj * HALF + cw + 4 * n);
#pragma unroll
                    for (int e = 0; e < 4; ++e) cv[bj][n][e] = __builtin_amdgcn_rsqf(sv[e] * (1.0f / 1024.0f) + 1e-6f); }
#pragma unroll
            for (int ai = 0; ai < 2; ++ai)
#pragma unroll
                for (int m = 0; m < 4; ++m) { bf16_t* rowp = O + (size_t)(row0 + ai * HALF + m * 16) * ldc + u.pn * BM + cw;
#pragma unroll
                    for (int bj = 0; bj < 2; ++bj) {
                        if (u.pm < 4) {
                            const f32x4 v0 = acc[ai][bj][m][0] * cv[bj][0], v1 = acc[ai][bj][m][1] * cv[bj][1];
                            bf16_t* gb = rowp + bj * HALF - 8 * (fq & 1) + 4 * (fq & 1);
                            u32x2 w0, w1; w0.x = cvtpk(v0[0], v0[1]); w0.y = cvtpk(v0[2], v0[3]); w1.x = cvtpk(v1[0], v1[1]); w1.y = cvtpk(v1[2], v1[3]);
                            *(u32x2*)gb = w0; *(u32x2*)(gb + 8) = w1;
                        } else store8(rowp + bj * HALF, acc[ai][bj][m][0] * cv[bj][0], acc[ai][bj][m][1] * cv[bj][1]); } }
        } else {
#pragma unroll
            for (int ai = 0; ai < 2; ++ai)
#pragma unroll
                for (int m = 0; m < 4; ++m) { const int row = row0 + ai * HALF + m * 16;
                    bf16_t* rowp = O + (size_t)row * ldc + u.pn * BM + cw; const bf16_t* gp = gate + (size_t)row * ldg + u.pn * BM + cw;
#pragma unroll
                    for (int bj = 0; bj < 2; ++bj) { const u32x4 gw = *(const u32x4*)(gp + bj * HALF);
                        f32x4 v0 = acc[ai][bj][m][0], v1 = acc[ai][bj][m][1];
                        v0[0] *= bf_lo(gw.x); v0[1] *= bf_hi(gw.x); v0[2] *= bf_lo(gw.y); v0[3] *= bf_hi(gw.y);
                        v1[0] *= bf_lo(gw.z); v1[1] *= bf_hi(gw.z); v1[2] *= bf_lo(gw.w); v1[3] *= bf_hi(gw.w);
                        if (mode == M_NAOUT) { const u32x4 pw = *(const u32x4*)(rowp + bj * HALF);
                            v0[0] += bf_lo(pw.x); v0[1] += bf_hi(pw.x); v0[2] += bf_lo(pw.y); v0[3] += bf_hi(pw.y);
                            v1[0] += bf_lo(pw.z); v1[1] += bf_hi(pw.z); v1[2] += bf_lo(pw.w); v1[3] += bf_hi(pw.w); }
                        store8(rowp + bj * HALF, v0, v1); } }
        }
    }
};

struct PanelRms {
    unsigned* xbuf;
    unsigned* cnt;
    __device__ __forceinline__ void publish(const f32x4 (&v)[2][2][4][2], const Unit& u, int wr, int wc, int fr, int fq, PG8_LAS unsigned char* lds, int wid, int lane) const {
        PG8_LAS float* P = (PG8_LAS float*)lds;
        PG8_LAS float* S = (PG8_LAS float*)(lds + 4096);
#pragma unroll
        for (int ai = 0; ai < 2; ++ai)
#pragma unroll
            for (int m = 0; m < 4; ++m) {
                float s = 0.f;
#pragma unroll
                for (int bj = 0; bj < 2; ++bj)
#pragma unroll
                    for (int n = 0; n < 2; ++n) { const f32x4 x = v[ai][bj][m][n]; s += (x[0] * x[0] + x[1] * x[1]) + (x[2] * x[2] + x[3] * x[3]); }
                s += shx(s, 16); s += shx(s, 32);
                if (fq == 0) P[(ai * HALF + wr * 64 + m * 16 + fr) * 4 + wc] = s;
            }
        asm volatile("s_waitcnt lgkmcnt(0)" ::: "memory"); __builtin_amdgcn_s_barrier(); asm volatile("" ::: "memory");
        const int row = wid * 32 + (lane & 31);
        if (lane < 32) {
            const float t = (P[row * 4 + 0] + P[row * 4 + 1]) + (P[row * 4 + 2] + P[row * 4 + 3]);
            __hip_atomic_store(xbuf + ((size_t)(u.pm * BM + row) * 4 + u.pn), __float_as_uint(t), __ATOMIC_RELAXED, __HIP_MEMORY_SCOPE_AGENT);
        }
        asm volatile("s_waitcnt vmcnt(0)" ::: "memory");
        if (lane == 0) __hip_atomic_fetch_add(cnt + 64 * u.pm, 1u, __ATOMIC_RELAXED, __HIP_MEMORY_SCOPE_AGENT);
    }
    __device__ __forceinline__ void finish(const Unit& u, PG8_LAS unsigned char* lds, int wid, int lane) const {
        PG8_LAS float* S = (PG8_LAS float*)(lds + 4096);
        const int row = wid * 32 + (lane & 31);
        if (wid == 0) {
            unsigned sp = 0;
            while ((unsigned)__builtin_amdgcn_readfirstlane(__hip_atomic_load(cnt + 64 * u.pm, __ATOMIC_RELAXED, __HIP_MEMORY_SCOPE_AGENT)) < 32u) { __builtin_amdgcn_s_sleep(2); if (++sp > (1u << 22)) break; }
            __builtin_amdgcn_fence(__ATOMIC_ACQUIRE, "agent");
        }
        asm volatile("s_waitcnt vmcnt(0) lgkmcnt(0)" ::: "memory"); __builtin_amdgcn_s_barrier(); asm volatile("" ::: "memory");
        if (lane < 32) {
            const unsigned* slot = xbuf + (size_t)(u.pm * BM + row) * 4; float t = 0.f;
#pragma unroll
            for (int k = 0; k < 4; ++k) t += __uint_as_float(__hip_atomic_load(slot + k, __ATOMIC_RELAXED, __HIP_MEMORY_SCOPE_AGENT));
            S[row] = 1.0f / sqrtf(t * (1.0f / 1024.0f) + 1e-6f);
        }
        asm volatile("s_waitcnt lgkmcnt(0)" ::: "memory"); __builtin_amdgcn_s_barrier(); asm volatile("" ::: "memory");
    }
};
struct EpiRes {
    static constexpr bool PERM = true, AFTER_DRAIN = false;
    const float* xin32; const bf16_t* xinb; float* xout; const float* gpost; int halfstep; bf16_t* xb; float* ssn; int last; PanelRms st1; PG8_LAS unsigned char* xl;
    __device__ __forceinline__ void operator()(f32x4 (&acc)[2][2][4][2], const Unit& u, int wr, int wc, int fr_, int fq_) const {
        int lane; asm volatile("v_mbcnt_lo_u32_b32 %0, -1, 0\n\tv_mbcnt_hi_u32_b32 %0, -1, %0" : "=v"(lane));
        const int fr = lane & 15, fq = lane >> 4, wid = wr * 4 + wc; (void)fr_; (void)fq_;
        PG8_LAS float* P = (PG8_LAS float*)xl;
        const PG8_LAS float* S = (const PG8_LAS float*)(xl + 4096);
        const int col0 = u.pn * BM + wc * 32 + 8 * fq;
        st1.publish(acc, u, wr, wc, fr, fq, xl, wid, lane);
        u32x4 xw[2][4][2];
        if (!xin32) {
#pragma unroll
            for (int ai = 0; ai < 2; ++ai)
#pragma unroll
                for (int m = 0; m < 4; ++m)
#pragma unroll
                    for (int bj = 0; bj < 2; ++bj) xw[ai][m][bj] = *(const u32x4*)(xinb + (size_t)(u.pm * BM + ai * HALF + wr * 64 + m * 16 + fr) * 1024 + col0 + bj * HALF);
        }
        st1.finish(u, xl, wid, lane);
        const float cmul = halfstep ? 0.5f : 1.0f;
        f32x4 gv[2][2];
#pragma unroll
        for (int bj = 0; bj < 2; ++bj)
#pragma unroll
            for (int n = 0; n < 2; ++n) gv[bj][n] = *(const f32x4*)(gpost + col0 + bj * HALF + 4 * n) * cmul;
#pragma unroll
        for (int ai = 0; ai < 2; ++ai)
#pragma unroll
            for (int m = 0; m < 4; ++m) { const int r = ai * HALF + wr * 64 + m * 16 + fr; const float nh = S[r]; const size_t off = (size_t)(u.pm * BM + r) * 1024 + col0;
                float s2 = 0.f;
#pragma unroll
                for (int bj = 0; bj < 2; ++bj) { f32x4 x1[2], xo[2];
                    if (xin32) { xo[0] = *(const f32x4*)(xin32 + off + bj * HALF); xo[1] = *(const f32x4*)(xin32 + off + bj * HALF + 4); }
                    else { const u32x4 w = xw[ai][m][bj]; xo[0] = (f32x4){bf_lo(w.x), bf_hi(w.x), bf_lo(w.y), bf_hi(w.y)}; xo[1] = (f32x4){bf_lo(w.z), bf_hi(w.z), bf_lo(w.w), bf_hi(w.w)}; }
#pragma unroll
                    for (int n = 0; n < 2; ++n) { x1[n] = xo[n] + gv[bj][n] * acc[ai][bj][m][n] * nh;
                        s2 += (x1[n][0] * x1[n][0] + x1[n][1] * x1[n][1]) + (x1[n][2] * x1[n][2] + x1[n][3] * x1[n][3]); }
                    if (!last) store8(xb + off + bj * HALF, x1[0], x1[1]);
                    else { *(f32x4*)(xout + off + bj * HALF) = x1[0]; *(f32x4*)(xout + off + bj * HALF + 4) = x1[1]; } }
                if (!last) { s2 += shx(s2, 16); s2 += shx(s2, 32); if (fq == 0) P[r * 4 + wc] = s2; }
                if (m & 1) asm volatile("" ::: "memory"); }
        if (last) return;
        asm volatile("s_waitcnt lgkmcnt(0)" ::: "memory"); __builtin_amdgcn_s_barrier(); asm volatile("" ::: "memory");
        if (lane < 32) { const int row = wid * 32 + lane; const float t = (P[row * 4 + 0] + P[row * 4 + 1]) + (P[row * 4 + 2] + P[row * 4 + 3]);
            __hip_atomic_fetch_add(ssn + u.pm * BM + row, t, __ATOMIC_RELAXED, __HIP_MEMORY_SCOPE_AGENT); }
    }
};
struct OneUnit { Unit u;
    __host__ __device__ bool next(int i, Unit& o) const { if (i != 0) return false; o = u; return true; }
    __device__ __forceinline__ void a_ready(const Unit&) const {}
    __device__ __forceinline__ void done(const Unit&) const {}
};

template <class Epi, class Sched, bool ALIGN_EPI = false, bool SP2 = false>
__device__ __forceinline__ void gemm_phase(PG8_LAS unsigned char* lds, const Gemm g, const Sched& S, const Epi& E, const int wid_) {
    int wid = wid_; asm volatile("" : "+s"(wid)); int lane; asm volatile("v_mbcnt_lo_u32_b32 %0, -1, 0\n\tv_mbcnt_hi_u32_b32 %0, -1, %0" : "=v"(lane)); const int tid = wid * 64 + lane, wr = wid >> 2, wc = wid & 3, fr = lane & 15, fq = lane >> 4;
    const int K = g.K, nt = K / BK;
    unsigned voffA[2], voffB[2];
#pragma unroll
    for (int i = 0; i < 2; ++i) { int R, C; stage_rc(tid * 16 + i * 8192, R, C); const int Rb = Epi::PERM ? ((R & ~31) + perm32(R & 31)) : R;
        voffA[i] = (unsigned)(R * g.lda + C) * 2u; voffB[i] = (unsigned)(Rb * g.ldb + C) * 2u; }
    const size_t kstep = (size_t)(BK * 2);
    const size_t hstepA = (size_t)HALF * g.lda * 2, hstepB = (size_t)HALF * g.ldb * 2;
    const size_t tstepA = 2 * hstepA, tstepB = 2 * hstepB;
    const unsigned ldsw = (unsigned)wid * 1024u;
    const int aoff = lds_byte(wr * 64 + fr, fq * 8), boff = lds_byte(wc * 32 + fr, fq * 8);
#define PG8_SA(b, h) (((b) * 2 + (h)) * HTB)
#define PG8_SB(b, h) ((4 + (b) * 2 + (h)) * HTB)
#define PG8_STAGE(bufoff, gbase, voff) do { _Pragma("unroll") for (int _i = 0; _i < 2; ++_i) \
        __builtin_amdgcn_global_load_lds((const unsigned*)((const char*)(gbase) + (voff)[_i]), (PG8_LAS unsigned*)(lds + (bufoff) + ldsw + _i * 8192), 16, 0, 0); } while (0)
#define PG8_LDA(dst, b, h) do { _Pragma("unroll") for (int m = 0; m < 4; ++m) _Pragma("unroll") for (int k = 0; k < 2; ++k) dst[m][k] = *(const PG8_LAS bf16x8*)(lds + PG8_SA(b, h) + aoff + m * 2048 + k * 1024); } while (0)
#define PG8_LDB(dst, b, h) do { _Pragma("unroll") for (int n = 0; n < 2; ++n) _Pragma("unroll") for (int k = 0; k < 2; ++k) dst[n][k] = *(const PG8_LAS bf16x8*)(lds + PG8_SB(b, h) + boff + n * 2048 + k * 1024); } while (0)
#define PG8_MMA(ai, bj, At, Bt) do { __builtin_amdgcn_s_setprio(1); _Pragma("unroll") for (int m = 0; m < 4; ++m) _Pragma("unroll") for (int n = 0; n < 2; ++n) _Pragma("unroll") for (int k = 0; k < 2; ++k) \
        acc[ai][bj][m][n] = __builtin_amdgcn_mfma_f32_16x16x32_bf16(Bt[n][k], At[m][k], acc[ai][bj][m][n], 0, 0, 0); __builtin_amdgcn_s_setprio(0); } while (0)
#define PG8_WAIT_V(n) asm volatile("s_waitcnt vmcnt(" #n ")" ::: "memory")
#define PG8_WAIT_L(n) asm volatile("s_waitcnt lgkmcnt(" #n ")" ::: "memory")
#define PG8_BAR __builtin_amdgcn_s_barrier()
#define PG8_SCHED __builtin_amdgcn_sched_barrier(0)
    Unit cur, nxt; int ui = 0;
    if (!S.next(0, cur)) return;
    f32x4 acc[2][2][4][2];
#pragma unroll
    for (int a = 0; a < 2; ++a)
#pragma unroll
        for (int b = 0; b < 2; ++b)
#pragma unroll
            for (int m = 0; m < 4; ++m)
#pragma unroll
                for (int n = 0; n < 2; ++n) acc[a][b][m][n] = (f32x4){0.f, 0.f, 0.f, 0.f};
    bf16x8 At[4][2], B0[2][2], B1[2][2];
    const char* cA = (const char*)g.A + (size_t)cur.pm * tstepA; const char* cB = (const char*)g.Bt + (size_t)cur.pn * tstepB;
    S.a_ready(cur);
    if constexpr (SP2) {
        PG8_STAGE(PG8_SB(0, 0), cB, voffB); PG8_STAGE(PG8_SB(0, 1), cB + hstepB, voffB); PG8_STAGE(PG8_SA(0, 0), cA, voffA); PG8_STAGE(PG8_SA(0, 1), cA + hstepA, voffA);
        if (wr == 1) PG8_BAR;
        PG8_WAIT_V(2); PG8_BAR;
        PG8_STAGE(PG8_SB(1, 0), cB + kstep, voffB); PG8_STAGE(PG8_SA(1, 0), cA + kstep, voffA); PG8_STAGE(PG8_SB(1, 1), cB + hstepB + kstep, voffB);
        PG8_WAIT_V(6); PG8_BAR;
    } else {
        PG8_STAGE(PG8_SB(0, 0), cB, voffB); PG8_STAGE(PG8_SA(0, 0), cA, voffA); PG8_STAGE(PG8_SB(0, 1), cB + hstepB, voffB); PG8_STAGE(PG8_SA(0, 1), cA + hstepA, voffA);
        if (wr == 1) PG8_BAR;
        PG8_WAIT_V(4); PG8_BAR;
        PG8_STAGE(PG8_SB(1, 0), cB + kstep, voffB); PG8_STAGE(PG8_SA(1, 0), cA + kstep, voffA); PG8_STAGE(PG8_SB(1, 1), cB + hstepB + kstep, voffB);
        PG8_WAIT_V(6); PG8_BAR;
    }
    for (;;) {
        const bool has_next = S.next(ui + 1, nxt);
        const char* nA = has_next ? (const char*)g.A + (size_t)nxt.pm * tstepA : cA; const char* nB = has_next ? (const char*)g.Bt + (size_t)nxt.pn * tstepB : cB;
        for (int t = 0; t < nt; t += 2) {
            const bool last = (t == nt - 2);
            const char* a1 = cA + (size_t)(t + 1) * kstep;
            const char* a2 = last ? nA : cA + (size_t)(t + 2) * kstep; const char* b2 = last ? nB : cB + (size_t)(t + 2) * kstep;
            const char* a3 = a2 + kstep; const char* b3 = b2 + kstep;
            if (last && has_next) S.a_ready(nxt);
            if constexpr (SP2) {
            PG8_LDB(B0, 0, 0); PG8_LDB(B1, 0, 1); PG8_SCHED; PG8_LDA(At, 0, 0); PG8_STAGE(PG8_SA(1, 1), a1 + hstepA, voffA);
            PG8_WAIT_V(8); PG8_WAIT_L(0); PG8_BAR; PG8_MMA(0, 0, At, B0); PG8_MMA(0, 1, At, B1); PG8_BAR; PG8_SCHED;
            PG8_LDA(At, 0, 1); PG8_STAGE(PG8_SB(0, 0), b2, voffB); PG8_STAGE(PG8_SB(0, 1), b2 + hstepB, voffB); PG8_STAGE(PG8_SA(0, 0), a2, voffA);
            PG8_WAIT_V(8); PG8_WAIT_L(0); PG8_BAR; PG8_MMA(1, 0, At, B0); PG8_MMA(1, 1, At, B1); PG8_BAR; PG8_SCHED;
            PG8_LDB(B0, 1, 0); PG8_LDB(B1, 1, 1); PG8_SCHED; PG8_LDA(At, 1, 0); PG8_STAGE(PG8_SA(0, 1), a2 + hstepA, voffA);
            PG8_WAIT_V(8); PG8_WAIT_L(0); PG8_BAR; PG8_MMA(0, 0, At, B0); PG8_MMA(0, 1, At, B1); PG8_BAR; PG8_SCHED;
            PG8_LDA(At, 1, 1); PG8_STAGE(PG8_SB(1, 0), b3, voffB); PG8_STAGE(PG8_SB(1, 1), b3 + hstepB, voffB); PG8_STAGE(PG8_SA(1, 0), a3, voffA);
            PG8_WAIT_V(8); PG8_WAIT_L(0); PG8_BAR; PG8_MMA(1, 0, At, B0); PG8_MMA(1, 1, At, B1); PG8_BAR; PG8_SCHED;
            } else {
            PG8_LDB(B0, 0, 0); PG8_SCHED; PG8_LDA(At, 0, 0); PG8_STAGE(PG8_SA(1, 1), a1 + hstepA, voffA);
            PG8_WAIT_L(8); PG8_BAR; PG8_WAIT_L(0); PG8_MMA(0, 0, At, B0); PG8_BAR; PG8_SCHED;
            PG8_LDB(B1, 0, 1); PG8_STAGE(PG8_SB(0, 0), b2, voffB);
            PG8_BAR; PG8_WAIT_L(0); PG8_MMA(0, 1, At, B1); PG8_BAR;
            PG8_LDA(At, 0, 1); PG8_STAGE(PG8_SA(0, 0), a2, voffA);
            PG8_BAR; PG8_WAIT_L(0); PG8_MMA(1, 0, At, B0); PG8_BAR; PG8_SCHED;
            PG8_STAGE(PG8_SB(0, 1), b2 + hstepB, voffB);
            PG8_WAIT_V(6); PG8_BAR; PG8_MMA(1, 1, At, B1); PG8_BAR;
            PG8_LDB(B0, 1, 0); PG8_SCHED; PG8_LDA(At, 1, 0); PG8_STAGE(PG8_SA(0, 1), a2 + hstepA, voffA);
            PG8_WAIT_L(8); PG8_BAR; PG8_WAIT_L(0); PG8_MMA(0, 0, At, B0); PG8_BAR; PG8_SCHED;
            PG8_LDB(B1, 1, 1); PG8_STAGE(PG8_SB(1, 0), b3, voffB);
            PG8_BAR; PG8_WAIT_L(0); PG8_MMA(0, 1, At, B1); PG8_BAR;
            PG8_LDA(At, 1, 1); PG8_STAGE(PG8_SA(1, 0), a3, voffA);
            PG8_BAR; PG8_WAIT_L(0); PG8_MMA(1, 0, At, B0); PG8_BAR; PG8_SCHED;
            PG8_STAGE(PG8_SB(1, 1), b3 + hstepB, voffB);
            PG8_WAIT_V(6); PG8_BAR; PG8_MMA(1, 1, At, B1); PG8_BAR;
            }
        }
        if constexpr (ALIGN_EPI) { if (wr == 0) PG8_BAR; }
        if constexpr (!Epi::AFTER_DRAIN) { E(acc, cur, wr, wc, fr, fq); S.done(cur); }
        if (!has_next) break;
#pragma unroll
        for (int a = 0; a < 2; ++a)
#pragma unroll
            for (int b = 0; b < 2; ++b)
#pragma unroll
                for (int m = 0; m < 4; ++m)
#pragma unroll
                    for (int n = 0; n < 2; ++n) acc[a][b][m][n] = (f32x4){0.f, 0.f, 0.f, 0.f};
        cur = nxt; cA = nA; cB = nB; ++ui;
        if constexpr (ALIGN_EPI) { if (wr == 1) PG8_BAR; }
    }
    PG8_WAIT_V(0);
    if constexpr (!ALIGN_EPI) { if (wr == 0) PG8_BAR; }
    PG8_BAR;
    if constexpr (Epi::AFTER_DRAIN) { E.fused(acc, cur, wr, wc, fr, fq, lds, wid, lane); S.done(cur); }
#undef PG8_SA
#undef PG8_SB
#undef PG8_STAGE
#undef PG8_LDA
#undef PG8_LDB
#undef PG8_MMA
#undef PG8_WAIT_V
#undef PG8_WAIT_L
#undef PG8_BAR
#undef PG8_SCHED
}
}

#define LAS __attribute__((address_space(3)))
#define DI __device__ __forceinline__
typedef unsigned short bf16_t;
typedef short bf16x8 __attribute__((ext_vector_type(8)));
typedef short s16x4 __attribute__((ext_vector_type(4)));
typedef float f32x4 __attribute__((ext_vector_type(4)));
typedef float f32x16 __attribute__((ext_vector_type(16)));
typedef unsigned u32x4 __attribute__((ext_vector_type(4)));
typedef unsigned u32x2 __attribute__((ext_vector_type(2)));
using pg8::cvtpk; using pg8::bf_lo; using pg8::bf_hi;

constexpr int BATCH = 32, SEQ = 2048, D = 1024, M = BATCH * SEQ, DFF = 2816;
constexpr int MXW = 5120;
constexpr int VTROWS = 1536;
constexpr int VTP = 65536 + 128;
constexpr float EPS = 1e-6f;
constexpr int C_RQ = 0, C_RK = 512, C_RG = 1024, C_NQ = 2048, C_NK = 2560, C_GR = 3072, C_GN = 4096;

constexpr size_t OFF_W_F1IN = 0;
constexpr size_t OFF_W_F1OUT = OFF_W_F1IN + (size_t)2 * DFF * D * 2;
constexpr size_t OFF_W_MIXM = OFF_W_F1OUT + (size_t)D * DFF * 2;
constexpr size_t OFF_W_VT = OFF_W_MIXM + (size_t)MXW * D * 2;
constexpr size_t OFF_W_RETO = OFF_W_VT + (size_t)VTROWS * D * 2;
constexpr size_t OFF_W_NAO = OFF_W_RETO + (size_t)D * D * 2;
constexpr size_t OFF_W_MIXO = OFF_W_NAO + (size_t)D * 512 * 2;
constexpr size_t OFF_W_F2IN = OFF_W_MIXO + (size_t)D * D * 2;
constexpr size_t OFF_W_F2OUT = OFF_W_F2IN + (size_t)2 * DFF * D * 2;
constexpr size_t OFF_COS = OFF_W_F2OUT + (size_t)D * DFF * 2;
constexpr size_t OFF_SIN = OFF_COS + (size_t)SEQ * 64 * 4;
constexpr size_t OFF_RS = OFF_SIN + (size_t)SEQ * 64 * 4;
constexpr size_t OFF_BAR = OFF_RS + 3 * (size_t)M * 4;
constexpr size_t OFF_XCNT = OFF_BAR + 16384;
constexpr size_t XCNT_BANK = 256 * 64 * 4;
constexpr size_t OFF_XBUF = OFF_XCNT + 6 * XCNT_BANK;
constexpr size_t OFF_XB = OFF_XBUF + 2 * (size_t)M * 4 * 4;
constexpr size_t OFF_BIG = OFF_XB + (size_t)M * D * 2;
constexpr size_t OFF_MX = OFF_BIG;
constexpr size_t OFF_VT = OFF_MX + (size_t)M * MXW * 2;
constexpr size_t OFF_H = OFF_BIG;
constexpr size_t OFF_HOUT = OFF_H + (size_t)M * DFF * 2;
constexpr size_t WS_END = OFF_VT + (size_t)VTROWS * VTP * 2;
static_assert(OFF_HOUT + (size_t)M * D * 2 <= WS_END && (size_t)M * D * 2 <= (size_t)VTROWS * VTP * 2, "workspace overlays");
static_assert(OFF_XB % 256 == 0 && OFF_VT % 256 == 0 && OFF_HOUT % 256 == 0, "alignment");

#ifndef RET_LOOPS
#define RET_LOOPS 1
#endif
#ifndef NA_LOOPS
#define NA_LOOPS 1
#endif
#ifndef EXTRA_SYNCS
#define EXTRA_SYNCS 0
#endif
#ifndef RET_DRY
#define RET_DRY 0
#endif
#ifndef NA_DRY
#define NA_DRY 0
#endif
#ifndef REP_MASK
#define REP_MASK 0
#endif
constexpr int GRID = 256;
constexpr int LDS_BYTES = 155648;

struct Params { const float* in[18]; float* out; unsigned char* ws; };

DI int lane_id() { int l; asm volatile("v_mbcnt_lo_u32_b32 %0, -1, 0\n\tv_mbcnt_hi_u32_b32 %0, -1, %0" : "=v"(l)); return l; }
constexpr int PTAB_OFF = LDS_BYTES - 16 - 192;
DI const float* PIN(LAS unsigned char* lds, int i) {
    int a = PTAB_OFF + 8 * i; asm volatile("" : "+v"(a));
    volatile LAS unsigned* t = (volatile LAS unsigned*)(lds + a);
    const unsigned lo = (unsigned)__builtin_amdgcn_readfirstlane((int)t[0]), hi = (unsigned)__builtin_amdgcn_readfirstlane((int)t[1]);
    return (const float*)(((unsigned long long)hi << 32) | lo);
}
#define POUT(lds) ((float*)PIN(lds, 18))
#define PWS(lds) ((unsigned char*)PIN(lds, 19))
DI float wave_sum(float v) {
#pragma unroll
    for (int o = 1; o < 64; o <<= 1) v += shx(v, o);
    return v;
}
DI unsigned f2bf(float f) { unsigned u = __builtin_bit_cast(unsigned, f); return (u + 0x7fffu + ((u >> 16) & 1u)) >> 16; }

__device__ const float c_rope_inv[64] = {1.000000000e+00f, 8.639885187e-01f, 7.464760542e-01f, 6.449466944e-01f, 5.572264791e-01f, 4.814372659e-01f, 4.159561992e-01f, 3.593813777e-01f, 3.105013072e-01f, 2.682695687e-01f, 2.317818254e-01f, 2.002568096e-01f, 1.730195731e-01f, 1.494869143e-01f, 1.291549653e-01f, 1.115884036e-01f, 9.641107917e-02f, 8.329805732e-02f, 7.196855545e-02f, 6.218000501e-02f, 5.372281000e-02f, 4.641588405e-02f, 4.010278732e-02f, 3.464834765e-02f, 2.993576974e-02f, 2.586415969e-02f, 2.234633639e-02f, 1.930697635e-02f, 1.668100618e-02f, 1.441219542e-02f, 1.245197095e-02f, 1.075835899e-02f, 9.295095690e-03f, 8.030855097e-03f, 6.938566454e-03f, 5.994840525e-03f, 5.179473199e-03f, 4.475005437e-03f, 3.866353072e-03f, 3.340484342e-03f, 2.886139555e-03f, 2.493591513e-03f, 2.154434333e-03f, 1.861406374e-03f, 1.608233666e-03f, 1.389495214e-03f, 1.200507861e-03f, 1.037224894e-03f, 8.961504791e-04f, 7.742635789e-04f, 6.689548027e-04f, 5.779692437e-04f, 4.993587499e-04f, 4.314401885e-04f, 3.727593285e-04f, 3.220597573e-04f, 2.782559313e-04f, 2.404098923e-04f, 2.077113895e-04f, 1.794602285e-04f, 1.550515735e-04f, 1.339627634e-04f, 1.157422957e-04f, 9.999999747e-05f};
DI void conv_item(const float* W, int K, int N, const float* gain, bf16_t* dst, int drow0, float scale, int k0, int n0, LAS float* scr, int lane) {
#pragma unroll 8
    for (int i = 0; i < 32; ++i) { const int kk = 2 * i + (lane >> 5); const float g = gain ? gain[k0 + kk] * scale : scale;
        scr[kk * 33 + (lane & 31)] = W[(size_t)(k0 + kk) * N + n0 + (lane & 31)] * g; }
    asm volatile("s_waitcnt lgkmcnt(0)" ::: "memory");
    const int c = lane & 7;
#pragma unroll
    for (int j = 0; j < 4; ++j) { const int n = (lane >> 3) + 8 * j; const LAS float* s = scr + (8 * c) * 33 + n;
        u32x4 o; o.x = cvtpk(s[0 * 33], s[1 * 33]); o.y = cvtpk(s[2 * 33], s[3 * 33]); o.z = cvtpk(s[4 * 33], s[5 * 33]); o.w = cvtpk(s[6 * 33], s[7 * 33]);
        *(u32x4*)(dst + (size_t)(drow0 + n) * K + k0 + 8 * c) = o; }
    asm volatile("s_waitcnt lgkmcnt(0)" ::: "memory");
}

DI void prologue(LAS unsigned char* lds, int G, const int wave_s) {
    int wave = wave_s; asm volatile("" : "+s"(wave));
    const int lane = lane_id(), tid = wave * 64 + lane;
    unsigned char* ws = PWS(lds);
    LAS float* scr = (LAS float*)(lds + wave * 16384);
    const int gw = blockIdx.x * 8 + wave, NGW = G * 8;
    constexpr int I0 = 16 * 176, I1 = 44 * 32, I2 = 16 * 208, I3 = 16 * 32, I4 = 8 * 32, I5 = 16 * 32;
    constexpr int NITEMS = 2 * (I0 + I1) + I2 + I3 + I4 + I5;
    for (int it = gw; it < NITEMS; it += NGW) {
        int r = it;
        const float* W; const float* gain = nullptr; bf16_t* dst; int K, N, drow0, k0, n0; float scale = 1.0f;
        int mid;
        if (r < I0) mid = 0; else { r -= I0;
        if (r < I1) mid = 1; else { r -= I1;
        if (r < I2) mid = 2; else { r -= I2;
        if (r < I3) mid = 3; else { r -= I3;
        if (r < I4) mid = 4; else { r -= I4;
        if (r < I5) mid = 5; else { r -= I5;
        if (r < I0) mid = 6; else { r -= I0; mid = 7; } } } } } } }
        if (mid == 0 || mid == 6) {
            W = PIN(lds, mid == 0 ? 2 : 15); gain = PIN(lds, mid == 0 ? 1 : 14); K = D; N = 2 * DFF;
            const int nblk = N / 32; k0 = 64 * (r / nblk); n0 = 32 * (r % nblk);
            const int half = n0 >= DFF ? 1 : 0, j = n0 - half * DFF;
            drow0 = 256 * (j >> 7) + 128 * half + (j & 127);
            dst = (bf16_t*)(ws + (mid == 0 ? OFF_W_F1IN : OFF_W_F2IN));
        } else if (mid == 1 || mid == 7) {
            W = PIN(lds, mid == 1 ? 3 : 16); K = DFF; N = D;
            const int nblk = N / 32; k0 = 64 * (r / nblk); n0 = 32 * (r % nblk); drow0 = n0;
            dst = (bf16_t*)(ws + (mid == 1 ? OFF_W_F1OUT : OFF_W_F2OUT));
        } else if (mid == 2) {
            W = PIN(lds, 6); gain = PIN(lds, 5); K = D; N = 6656;
            const int nblk = N / 32; k0 = 64 * (r / nblk); n0 = 32 * (r % nblk);
            dst = (bf16_t*)(ws + OFF_W_MIXM);
            if (n0 < 1024) { const int q = n0 & 511, hh = q >> 7, d = q & 127;
                drow0 = (n0 < 512 ? C_RQ : C_RK) + 256 * (hh >> 1) + 128 * (d >> 6) + 64 * (hh & 1) + (d & 63);
                if (n0 >= 512) scale = 0.08838834764831845f; }
            else if (n0 < 2048) { dst = (bf16_t*)(ws + OFF_W_VT); drow0 = n0 - 1024; }
            else if (n0 < 3072) { drow0 = C_RG + (n0 - 2048); }
            else if (n0 < 3584) { drow0 = C_NQ + (n0 - 3072); scale = 0.125f; }
            else if (n0 < 4096) { drow0 = C_NK + (n0 - 3584); }
            else if (n0 < 4608) { dst = (bf16_t*)(ws + OFF_W_VT); drow0 = 1024 + (n0 - 4096); }
            else if (n0 < 5632) { drow0 = C_GR + (n0 - 4608); }
            else { drow0 = C_GN + (n0 - 5632); }
        } else {
            W = PIN(lds, mid == 3 ? 10 : (mid == 4 ? 11 : 12)); K = (mid == 4) ? 512 : D; N = D;
            const int nblk = N / 32; k0 = 64 * (r / nblk); n0 = 32 * (r % nblk); drow0 = n0;
            dst = (bf16_t*)(ws + (mid == 3 ? OFF_W_RETO : (mid == 4 ? OFF_W_NAO : OFF_W_MIXO)));
        }
        conv_item(W, K, N, gain, dst, drow0, scale, k0, n0, scr, lane);
    }
    { unsigned* xc = (unsigned*)(ws + OFF_XCNT); for (int i = blockIdx.x * 512 + tid; i < (int)(6 * XCNT_BANK / 4); i += G * 512) xc[i] = 0u; }
    float* cs = (float*)(ws + OFF_COS); float* sn = (float*)(ws + OFF_SIN);
    for (int idx = blockIdx.x * 512 + tid; idx < SEQ * 64; idx += G * 512) {
        const int pos = idx >> 6, i = idx & 63;
        const float inv = c_rope_inv[i];
        const float ang = (float)pos * inv;
        double rev = (double)ang * 0.15915494309189535; rev -= rint(rev);
        cs[idx] = __builtin_amdgcn_cosf((float)rev); sn[idx] = __builtin_amdgcn_sinf((float)rev);
    }
    const float* x = PIN(lds, 0); bf16_t* XB = (bf16_t*)(ws + OFF_XB); float* rs = (float*)(ws + OFF_RS);
    for (int row = gw; row < M; row += NGW) {
        const f32x4* xr = (const f32x4*)(x + (size_t)row * D) + lane;
        f32x4 v[4]; float ss = 0.f;
#pragma unroll
        for (int j = 0; j < 4; ++j) { v[j] = xr[64 * j]; ss += (v[j][0] * v[j][0] + v[j][1] * v[j][1]) + (v[j][2] * v[j][2] + v[j][3] * v[j][3]); }
        ss = wave_sum(ss);
        u32x2* o8 = (u32x2*)(XB + (size_t)row * D) + lane;
#pragma unroll
        for (int j = 0; j < 4; ++j) { u32x2 w; w.x = cvtpk(v[j][0], v[j][1]); w.y = cvtpk(v[j][2], v[j][3]); o8[64 * j] = w; }
        if (lane == 0) { rs[row] = ss; rs[M + row] = 0.f; rs[2 * M + row] = 0.f; }
    }
}

DI void elt_phase(const float* xold, const bf16_t* hb, const float* gpost, float cmul, float* xout, bf16_t* xb, float* rs, bool last, int G, const int wave_s) {
    int wave = wave_s; asm volatile("" : "+s"(wave));
    const int lane = lane_id(), tid = wave * 64 + lane;
    const int gw = blockIdx.x * 8 + wave, NGW = G * 8;
    f32x4 gp[4];
#pragma unroll
    for (int j = 0; j < 4; ++j) gp[j] = *((const f32x4*)gpost + lane + 64 * j) * cmul;
    for (int row = gw; row < M; row += NGW) {
        const u32x2* hp = (const u32x2*)(hb + (size_t)row * D) + lane;
        const f32x4* xr = (const f32x4*)(xold + (size_t)row * D) + lane;
        f32x4 h[4], xv[4]; float ss = 0.f;
#pragma unroll
        for (int j = 0; j < 4; ++j) { const u32x2 w = hp[64 * j]; xv[j] = xr[64 * j]; h[j] = (f32x4){bf_lo(w.x), bf_hi(w.x), bf_lo(w.y), bf_hi(w.y)};
            ss += (h[j][0] * h[j][0] + h[j][1] * h[j][1]) + (h[j][2] * h[j][2] + h[j][3] * h[j][3]); }
        const float nh = 1.0f / sqrtf(wave_sum(ss) * (1.0f / D) + EPS);
        float s2 = 0.f;
        f32x4* xo = (f32x4*)(xout + (size_t)row * D) + lane;
#pragma unroll
        for (int j = 0; j < 4; ++j) { xv[j] = xv[j] + gp[j] * h[j] * nh; xo[64 * j] = xv[j];
            s2 += (xv[j][0] * xv[j][0] + xv[j][1] * xv[j][1]) + (xv[j][2] * xv[j][2] + xv[j][3] * xv[j][3]); }
        if (!last) {
            s2 = wave_sum(s2);
            u32x2* o8 = (u32x2*)(xb + (size_t)row * D) + lane;
#pragma unroll
            for (int j = 0; j < 4; ++j) { u32x2 w; w.x = cvtpk(xv[j][0], xv[j][1]); w.y = cvtpk(xv[j][2], xv[j][3]); o8[64 * j] = w; }
            if (lane == 0) rs[row] = 1.0f / sqrtf(s2 * (1.0f / D) + EPS);
        }
    }
}

#define MFMA32(a, b, c) __builtin_amdgcn_mfma_f32_32x32x16_bf16((a), (b), (c), 0, 0, 0)
#define MFMA16(a, b, c) __builtin_amdgcn_mfma_f32_16x16x32_bf16((a), (b), (c), 0, 0, 0)
constexpr int RK_BYTES = 16384, RV_BYTES = 32768, RBUF = RK_BYTES + RV_BYTES;
constexpr int RTAB_OFF = 3 * RBUF;
static_assert(RTAB_OFF + 256 <= 155648 - 256, "mixer LDS");

DI bf16x8 ret_scale8(const bf16x8 v, const float w) {
    const u32x4 u = __builtin_bit_cast(u32x4, v); u32x4 o;
    o.x = cvtpk(bf_lo(u.x) * w, bf_hi(u.x) * w); o.y = cvtpk(bf_lo(u.y) * w, bf_hi(u.y) * w); o.z = cvtpk(bf_lo(u.z) * w, bf_hi(u.z) * w); o.w = cvtpk(bf_lo(u.w) * w, bf_hi(u.w) * w);
    return __builtin_bit_cast(bf16x8, o);
}
DI void ret_unit(LAS unsigned char* lds, bf16_t* MX, const bf16_t* VT, bf16_t* ST, int b, int hh, int qt, float lgf, float nlgb, int wave, const int mode) {
    const int qc = 256 * (hh >> 1) + 64 * (hh & 1);
    const size_t tok0 = (size_t)b * SEQ;
    const int q0w = qt * 256 + wave * 32;
    const int tid = wave * 64 + lane_id();
    const int lane = tid & 63, r = lane & 31, h = lane >> 5;
    int tq; bf16x8 qf[8];
    if (mode == 0) {
        tq = q0w + r;
        const bf16_t* qrow = MX + (tok0 + tq) * MXW + C_RQ + qc + 8 * h;
#pragma unroll
        for (int s = 0; s < 8; ++s) qf[s] = *(const bf16x8*)(qrow + (s >> 2) * 128 + (s & 3) * 16);
    } else {
        tq = (wave < 4) ? qt * 256 + 255 : qt * 256;
        const int target = 32 * (wave & 3) + r;
#pragma unroll
        for (int s = 0; s < 8; ++s) { const bool hit = ((target >> 4) == s) && (((target >> 3) & 1) == h); const int j = target & 7;
            u32x4 w; w.x = (hit && (j >> 1) == 0) ? ((j & 1) ? 0x3F800000u : 0x00003F80u) : 0u; w.y = (hit && (j >> 1) == 1) ? ((j & 1) ? 0x3F800000u : 0x00003F80u) : 0u;
            w.z = (hit && (j >> 1) == 2) ? ((j & 1) ? 0x3F800000u : 0x00003F80u) : 0u; w.w = (hit && (j >> 1) == 3) ? ((j & 1) ? 0x3F800000u : 0x00003F80u) : 0u;
            qf[s] = __builtin_bit_cast(bf16x8, w); }
    }
    const bf16_t* Kb = MX + tok0 * MXW + C_RK + qc;
    const bf16_t* Vb = VT + (size_t)(hh * 256) * VTP + tok0;
    const bf16_t* Sb = ST + ((size_t)((b * 4 + hh) * 8) << 16);
    const int kt0 = 4 * qt, NT = mode ? 4 : 8;
#define RET_ISSUE(t_, buf_) do { const int tt_ = (t_); const int ln_ = lane_id();     \
        const char* Kt_ = (const char*)Kb + (size_t)(kt0 + (tt_ < 4 ? tt_ : 0)) * (64 * MXW * 2); \
        _Pragma("unroll") for (int i_ = 0; i_ < 2; ++i_) { const int key_ = 4 * (wave * 2 + i_) + (ln_ >> 4), ck_ = (ln_ & 15) ^ (key_ & 15); \
            __builtin_amdgcn_global_load_lds((const unsigned*)(Kt_ + (unsigned)(key_ * MXW + (ck_ >> 3) * 128 + (ck_ & 7) * 8) * 2u), (LAS unsigned*)(lds + (buf_) * RBUF + (wave * 2 + i_) * 1024), 16, 0, 0); } \
        if (tt_ < 4) { const char* Vt_ = (const char*)Vb + (size_t)(kt0 + tt_) * 128; \
            _Pragma("unroll") for (int i_ = 0; i_ < 4; ++i_) { const int dv_ = 8 * (wave * 4 + i_) + (ln_ >> 3), c_ = (ln_ & 7) ^ ((dv_ >> 1) & 7); \
                __builtin_amdgcn_global_load_lds((const unsigned*)(Vt_ + (unsigned)(dv_ * VTP + c_ * 8) * 2u), (LAS unsigned*)(lds + (buf_) * RBUF + RK_BYTES + (wave * 4 + i_) * 1024), 16, 0, 0); } \
        } else { const int dr_ = (tt_ - 4) >> 1, pp_ = (tt_ - 4) & 1, nn_ = dr_ ? (qt < 7 ? qt + 1 : 7) : (qt > 0 ? qt - 1 : 0);     \
            const char* St_ = (const char*)(Sb + ((size_t)nn_ << 16) + dr_ * 128 + pp_ * 64); \
            _Pragma("unroll") for (int i_ = 0; i_ < 4; ++i_) { const int dv_ = 8 * (wave * 4 + i_) + (ln_ >> 3), c_ = (ln_ & 7) ^ ((dv_ >> 1) & 7); \
                __builtin_amdgcn_global_load_lds((const unsigned*)(St_ + (unsigned)(dv_ * 256 + c_ * 8) * 2u), (LAS unsigned*)(lds + (buf_) * RBUF + RK_BYTES + (wave * 4 + i_) * 1024), 16, 0, 0); } } } while (0)
    const int kA = r * 256 + 16 * (h ^ (r & 1)), sx32 = ((r & 15) >> 1) * 32;
    const int vA = r * 128, mv16 = (((r >> 1) & 7) * 16) ^ (h * 16);
    const LAS float* tab = (const LAS float*)(lds + RTAB_OFF);
    f32x16 z[8];
#pragma unroll
    for (int d = 0; d < 8; ++d)
#pragma unroll
        for (int i = 0; i < 16; ++i) z[d][i] = 0.f;
    RET_ISSUE(0, 0); RET_ISSUE(1, 1);
    int cur = 0, nx2 = 2;
#pragma unroll 1
    for (int t = 0; t < NT; ++t) {
        if (t + 1 < NT) asm volatile("s_waitcnt vmcnt(6)" ::: "memory");
        else asm volatile("s_waitcnt vmcnt(0)" ::: "memory");
        __builtin_amdgcn_s_barrier();
        asm volatile("" ::: "memory");
        if (t + 2 < NT) RET_ISSUE(t + 2, nx2);
        const LAS unsigned char* Kl = lds + cur * RBUF;
        const LAS unsigned char* Vl = Kl + RK_BYTES;
        bf16x8 f4[4];
        if (t < 4) {
            const int kt = kt0 + t;
            const bool fwd = (mode == 0) && (kt * 64 + 64 <= q0w), bwd = (mode == 0) && (kt * 64 >= q0w + 32);
#pragma unroll
            for (int kb = 0; kb < 2; ++kb) {
                f32x16 x;
#pragma unroll
                for (int i = 0; i < 16; ++i) x[i] = 0.f;
                { bf16x8 af[8];
#pragma unroll
                  for (int s = 0; s < 8; ++s) af[s] = *(const LAS bf16x8*)(Kl + kA + ((s * 32) ^ sx32) + kb * 8192);
#pragma unroll
                  for (int s = 0; s < 8; ++s) x = MFMA32(af[s], qf[s], x); }
                __builtin_amdgcn_sched_barrier(0);
                const float dq = (float)(tq - kt * 64 - 4 * h - 32 * kb);
                if (fwd || bwd) {
                    const float cf = fwd ? lgf : nlgb;
                    const float A0 = __builtin_amdgcn_exp2f(cf * dq);
                    const LAS f32x4* T = (const LAS f32x4*)(tab + (fwd ? 0 : 16));
                    const f32x4 c0 = T[0], c1 = T[1], c2 = T[2], c3 = T[3];
#pragma unroll
                    for (int e = 0; e < 4; ++e) { x[e] *= A0 * c0[e]; x[4 + e] *= A0 * c1[e]; x[8 + e] *= A0 * c2[e]; x[12 + e] *= A0 * c3[e]; }
                } else {
#pragma unroll
                    for (int i = 0; i < 16; ++i) { const float v0 = dq - (float)((i & 3) + 8 * (i >> 2)); x[i] *= __builtin_amdgcn_exp2f(fminf(lgf * v0, nlgb * v0)); }
                }
#pragma unroll
                for (int s2 = 0; s2 < 2; ++s2) {
                    u32x4 pw; pw.x = cvtpk(x[8 * s2 + 0], x[8 * s2 + 1]); pw.y = cvtpk(x[8 * s2 + 2], x[8 * s2 + 3]); pw.z = cvtpk(x[8 * s2 + 4], x[8 * s2 + 5]); pw.w = cvtpk(x[8 * s2 + 6], x[8 * s2 + 7]);
                    f4[2 * kb + s2] = __builtin_bit_cast(bf16x8, pw);
                }
                __builtin_amdgcn_sched_barrier(0);
            }
        } else {
            const int dr = (t - 4) >> 1, pp = (t - 4) & 1;
            const float wgt = dr ? (qt < 7 ? __builtin_amdgcn_exp2f(nlgb * (float)(tq - 256 * (qt + 1))) : 0.f) : (qt > 0 ? __builtin_amdgcn_exp2f(lgf * (float)(tq - 256 * qt + 1)) : 0.f);
#pragma unroll
            for (int f = 0; f < 4; ++f) {
                const unsigned msk = pp ? 0xffffffffu : 0u; const u32x4 lo4 = __builtin_bit_cast(u32x4, qf[f]), hi4 = __builtin_bit_cast(u32x4, qf[4 + f]);
                u32x4 sv; sv.x = (lo4.x & ~msk) | (hi4.x & msk); sv.y = (lo4.y & ~msk) | (hi4.y & msk); sv.z = (lo4.z & ~msk) | (hi4.z & msk); sv.w = (lo4.w & ~msk) | (hi4.w & msk);
                f4[f] = ret_scale8(__builtin_bit_cast(bf16x8, sv), wgt); }
            __builtin_amdgcn_sched_barrier(0);
        }
#pragma unroll
        for (int f = 0; f < 4; ++f) {
            const int vo = vA + ((f * 32) ^ mv16);
#pragma unroll
            for (int db = 0; db < 8; ++db) z[db] = MFMA32(f4[f], *(const LAS bf16x8*)(Vl + vo + db * 4096), z[db]);
            __builtin_amdgcn_sched_barrier(0);
        }
        cur = (cur == 2) ? 0 : cur + 1; nx2 = (nx2 == 2) ? 0 : nx2 + 1;
    }
#undef RET_ISSUE
    const int tide = lane_id();
    const int le = tide & 63, re = le & 31, he = le >> 5;
    if (mode != 0) {
        bf16_t* sp = ST + ((size_t)(((b * 4 + hh) * 8) + qt) << 16) + 32 * wave + 4 * he;
#pragma unroll
        for (int db = 0; db < 8; ++db)
#pragma unroll
            for (int g = 0; g < 4; ++g) { u32x2 w; w.x = cvtpk(z[db][4 * g + 0], z[db][4 * g + 1]); w.y = cvtpk(z[db][4 * g + 2], z[db][4 * g + 3]);
                *(u32x2*)(sp + (size_t)(db * 32 + re) * 256 + 8 * g) = w; }
        return;
    }
    f32x16 nrm;
#pragma unroll
    for (int i = 0; i < 16; ++i) {
        float ss = 0.f;
#pragma unroll
        for (int db = 0; db < 8; ++db) ss += z[db][i] * z[db][i];
        ss += shx(ss, 1); ss += shx(ss, 2); ss += shx(ss, 4); ss += shx(ss, 8); ss += shx(ss, 16);
        nrm[i] = 1.0f / sqrtf(ss * (1.0f / 256.0f) + EPS);
    }
    __syncthreads();
    LAS unsigned char* T = lds + wave * 8704;
#pragma unroll
    for (int hf = 0; hf < 2; ++hf) {
#pragma unroll
        for (int i = 0; i < 16; ++i) { const int q = (i & 3) + 8 * (i >> 2) + 4 * he;
#pragma unroll
            for (int d4 = 0; d4 < 4; ++d4) *(LAS bf16_t*)(T + q * 272 + (d4 * 32 + re) * 2) = (bf16_t)f2bf(z[hf * 4 + d4][i] * nrm[i]); }
        asm volatile("s_waitcnt lgkmcnt(0)" ::: "memory");
#pragma unroll
        for (int k = 0; k < 8; ++k) { const int id = le + 64 * k, q = id >> 4, ch = id & 15;
            const u32x4 ov = *(const LAS u32x4*)(T + q * 272 + ch * 16);
            bf16_t* gp = MX + (tok0 + q0w + q) * MXW + C_RG + hh * 256 + hf * 128 + ch * 8;
            const u32x4 gv = *(const u32x4*)gp;
            u32x4 w; w.x = cvtpk(bf_lo(ov.x) * bf_lo(gv.x), bf_hi(ov.x) * bf_hi(gv.x)); w.y = cvtpk(bf_lo(ov.y) * bf_lo(gv.y), bf_hi(ov.y) * bf_hi(gv.y));
            w.z = cvtpk(bf_lo(ov.z) * bf_lo(gv.z), bf_hi(ov.z) * bf_hi(gv.z)); w.w = cvtpk(bf_lo(ov.w) * bf_lo(gv.w), bf_hi(ov.w) * bf_hi(gv.w));
            *(u32x4*)gp = w; }
        asm volatile("s_waitcnt lgkmcnt(0)" ::: "memory");
    }
}

constexpr int NA_SLOT = 16384, NA_KROW = 8192;
constexpr int NA_RELB_OFF = 8 * NA_SLOT;
constexpr int NA_MRG_OFF = NA_RELB_OFF + 2048;
constexpr int NA_LDS_END = NA_MRG_OFF + 4 * 64 * 18 * 4;
static_assert(NA_LDS_END <= LDS_BYTES - 256, "NA LDS map");
DI void na_phase(LAS unsigned char* lds, int G, int vcu, const int wave_s, const bool do_store = true) {
    int wave = wave_s; asm volatile("" : "+s"(wave));
    const int lane = lane_id(), tid = wave * 64 + lane;
    const int fr = lane & 15, fq = lane >> 4, cb = wave & 3, kh = wave >> 2;
    bf16_t* MX = (bf16_t*)(PWS(lds) + OFF_MX); const bf16_t* VT = (const bf16_t*)(PWS(lds) + OFF_VT);
    unsigned koff, voff;
    { const int tok = 8 * wave + (lane >> 3), c = (lane & 7) ^ ((tok >> 1) & 7); koff = (unsigned)(tok * MXW + c * 8) * 2u; }
    { const int d = 8 * wave + (lane >> 3), c = (lane & 7) ^ (d & 7); voff = (unsigned)(d * VTP + c * 8) * 2u; }
    const int kc0 = min(max(16 * cb - 8, 0), 32);
    const int qcol = cb * 16 + fr, wst = min(max(qcol - 8, 0), 48);
    const LAS float* rb = (const LAS float*)(lds + NA_RELB_OFF);
#pragma unroll 1
    for (int bh = vcu; bh < BATCH * 8; bh += G) {
        const int b = bh >> 3, h = bh & 7;
        const char* Kbase = (const char*)(MX + (size_t)b * SEQ * MXW + C_NK + h * 64);
        const char* Vbase = (const char*)(VT + (size_t)(1024 + h * 64) * VTP + (size_t)b * SEQ);
#define NA_ISSUE_ROW(row_) do { const int rw_ = (row_); \
        __builtin_amdgcn_global_load_lds((const unsigned*)(Kbase + (size_t)rw_ * (64 * MXW * 2) + koff), (LAS unsigned*)(lds + (rw_ & 7) * NA_SLOT + wave * 1024), 16, 0, 0); \
        __builtin_amdgcn_global_load_lds((const unsigned*)(Vbase + (size_t)rw_ * 128 + voff), (LAS unsigned*)(lds + (rw_ & 7) * NA_SLOT + NA_KROW + wave * 1024), 16, 0, 0); } while (0)
        __syncthreads();
        if (tid < 465) ((LAS float*)(lds + NA_RELB_OFF))[tid] = PIN(lds, 9)[h * 465 + tid];
#pragma unroll
        for (int i = 0; i < 8; ++i) NA_ISSUE_ROW(i);
        asm volatile("s_waitcnt lgkmcnt(0)" ::: "memory"); __builtin_amdgcn_s_barrier(); asm volatile("" ::: "memory");
        f32x4 bm[8];
#pragma unroll
        for (int w = 0; w < 4; ++w)
#pragma unroll
            for (int cblk = 0; cblk < 2; ++cblk)
#pragma unroll
                for (int j = 0; j < 4; ++j) {
                    const int keycol = kc0 + cblk * 16 + 4 * fq + j;
                    const bool valid = (keycol >= wst) && (keycol < wst + 16);
                    const int cidx = min(max(keycol - qcol + 15, 0), 30);
                    bm[w * 2 + cblk][j] = valid ? rb[(4 * kh + w + 3) * 31 + cidx] : -1.0e30f;
                }
        float mrun = 0.f, lrun = 0.f; f32x4 ot[4]; bf16_t* outp = nullptr;
#pragma unroll
        for (int d = 0; d < 4; ++d) ot[d] = (f32x4){0.f, 0.f, 0.f, 0.f};
        bf16x8 qn0, qn1;
        { const bf16_t* qp = MX + ((size_t)b * SEQ + cb * 16 + fr) * MXW + C_NQ + h * 64 + 8 * fq; qn0 = *(const bf16x8*)qp; qn1 = *(const bf16x8*)(qp + 32); }
#pragma unroll 1
        for (int r = 0; r <= 32; ++r) {
            asm volatile("s_waitcnt vmcnt(0) lgkmcnt(0)" ::: "memory");
            __builtin_amdgcn_s_barrier();
            asm volatile("" ::: "memory");
            const int rs_ = min(max(r - 4, 0), 24);
            const bool has_new = (r >= 5 && r <= 28);
            if (has_new) NA_ISSUE_ROW(rs_ + 7);
            asm volatile("" ::: "memory");
            if (r > 0 && kh == 0) {
                const LAS float* mp = (const LAS float*)(lds + NA_MRG_OFF) + (cb * 64 + lane) * 18;
                const float m1 = mp[16], l1 = mp[17];
                const float mm = fmaxf(mrun, m1), a0 = __builtin_amdgcn_exp2f((mrun - mm) * 1.44269504f), a1 = __builtin_amdgcn_exp2f((m1 - mm) * 1.44269504f);
                float l0 = lrun; l0 += shx(l0, 16); l0 += shx(l0, 32);
                const float il = 1.0f / (l0 * a0 + l1 * a1);
#pragma unroll
                for (int db = 0; db < 4; ++db) { const f32x4 o1 = *(const LAS f32x4*)(mp + 4 * db); const f32x4 o = (ot[db] * a0 + o1 * a1) * il;
                    u32x2 w; w.x = cvtpk(o[0], o[1]); w.y = cvtpk(o[2], o[3]); if (do_store) *(u32x2*)(outp + db * 16) = w; }
            }
            if (r == 32) break;
            const size_t tokq = (size_t)b * SEQ + r * 64 + cb * 16 + fr;
            const bf16x8 qf0 = qn0, qf1 = qn1;
            outp = MX + tokq * MXW + C_NQ + h * 64 + 4 * fq;
            if (r + 1 < 32) { const bf16_t* qp = MX + (tokq + 64) * MXW + C_NQ + h * 64 + 8 * fq; qn0 = *(const bf16x8*)qp; qn1 = *(const bf16x8*)(qp + 32); }
            f32x4 st[6];
#pragma unroll
            for (int rowl = 0; rowl < 3; ++rowl) {
                const LAS unsigned char* Kl = lds + ((rs_ + 4 * kh + rowl) & 7) * NA_SLOT;
#pragma unroll
                for (int cblk = 0; cblk < 2; ++cblk) {
                    const int tok = kc0 + cblk * 16 + fr, sw = (tok >> 1) & 7;
                    const bf16x8 a0 = *(const LAS bf16x8*)(Kl + tok * 128 + ((fq ^ sw) * 16)), a1 = *(const LAS bf16x8*)(Kl + tok * 128 + (((4 + fq) ^ sw) * 16));
                    f32x4 c = {0.f, 0.f, 0.f, 0.f};
                    c = MFMA16(a0, qf0, c); c = MFMA16(a1, qf1, c); st[rowl * 2 + cblk] = c;
                }
            }
            float mloc = -3.0e38f;
            const bool interior = (r >= 4 && r <= 28);
            if (interior) {
#pragma unroll
                for (int i = 0; i < 6; ++i)
#pragma unroll
                    for (int j = 0; j < 4; ++j) { const float sv = st[i][j] + bm[i][j]; st[i][j] = sv; mloc = fmaxf(mloc, sv); }
            } else
#pragma unroll
            for (int rowl = 0; rowl < 3; ++rowl) {
                const int ridx = rs_ + 4 * kh + rowl - r + 7;
#pragma unroll
                for (int cblk = 0; cblk < 2; ++cblk)
#pragma unroll
                    for (int j = 0; j < 4; ++j) {
                        const int keycol = kc0 + cblk * 16 + 4 * fq + j;
                        const bool valid = (keycol >= wst) && (keycol < wst + 16);
                        const int cidx = min(max(keycol - qcol + 15, 0), 30);
                        const float sv = valid ? st[rowl * 2 + cblk][j] + rb[ridx * 31 + cidx] : -1.0e30f;
                        st[rowl * 2 + cblk][j] = sv; mloc = fmaxf(mloc, sv);
                    }
            }
            mloc = fmaxf(mloc, shx(mloc, 16)); mloc = fmaxf(mloc, shx(mloc, 32));
            mrun = mloc; lrun = 0.f;
#pragma unroll
            for (int d = 0; d < 4; ++d) ot[d] = (f32x4){0.f, 0.f, 0.f, 0.f};
#pragma unroll
            for (int i = 0; i < 6; ++i)
#pragma unroll
                for (int j = 0; j < 4; ++j) { const float pv = __builtin_amdgcn_exp2f((st[i][j] - mrun) * 1.44269504f); st[i][j] = pv; lrun += pv; }
            const int ch = (kc0 >> 3) + (fq >> 1);
#pragma unroll
            for (int rowl = 0; rowl < 3; ++rowl) {
                u32x4 pw; pw.x = cvtpk(st[rowl * 2][0], st[rowl * 2][1]); pw.y = cvtpk(st[rowl * 2][2], st[rowl * 2][3]); pw.z = cvtpk(st[rowl * 2 + 1][0], st[rowl * 2 + 1][1]); pw.w = cvtpk(st[rowl * 2 + 1][2], st[rowl * 2 + 1][3]);
                const bf16x8 pb = __builtin_bit_cast(bf16x8, pw);
                const LAS unsigned char* Vl = lds + ((rs_ + 4 * kh + rowl) & 7) * NA_SLOT + NA_KROW;
#pragma unroll
                for (int db = 0; db < 4; ++db) {
                    const LAS unsigned char* vrow = Vl + (db * 16 + fr) * 128 + (fq & 1) * 8;
                    const s16x4 lo = *(const LAS s16x4*)(vrow + ((ch ^ (fr & 7)) * 16)), hi = *(const LAS s16x4*)(vrow + (((ch + 2) ^ (fr & 7)) * 16));
                    ot[db] = MFMA16(__builtin_shufflevector(lo, hi, 0, 1, 2, 3, 4, 5, 6, 7), pb, ot[db]);
                }
            }
            if (r + 1 < 32) asm volatile("s_waitcnt vmcnt(2)" ::: "memory"); else asm volatile("s_waitcnt vmcnt(0)" ::: "memory");
            __builtin_amdgcn_s_barrier();
            asm volatile("" ::: "memory");
            {
                const int rowa = rs_ + 4 * kh + 3;
                const LAS unsigned char* Kl = lds + (rowa & 7) * NA_SLOT;
                f32x4 s2[2];
#pragma unroll
                for (int cblk = 0; cblk < 2; ++cblk) {
                    const int tok = kc0 + cblk * 16 + fr, sw = (tok >> 1) & 7;
                    const bf16x8 a0 = *(const LAS bf16x8*)(Kl + tok * 128 + ((fq ^ sw) * 16)), a1 = *(const LAS bf16x8*)(Kl + tok * 128 + (((4 + fq) ^ sw) * 16));
                    f32x4 c = {0.f, 0.f, 0.f, 0.f};
                    c = MFMA16(a0, qf0, c); c = MFMA16(a1, qf1, c); s2[cblk] = c;
                }
                const int ridx = rowa - r + 7;
                float ml2 = -3.0e38f;
                if (interior) {
#pragma unroll
                    for (int cblk = 0; cblk < 2; ++cblk)
#pragma unroll
                        for (int j = 0; j < 4; ++j) { const float sv = s2[cblk][j] + bm[6 + cblk][j]; s2[cblk][j] = sv; ml2 = fmaxf(ml2, sv); }
                } else
#pragma unroll
                for (int cblk = 0; cblk < 2; ++cblk)
#pragma unroll
                    for (int j = 0; j < 4; ++j) {
                        const int keycol = kc0 + cblk * 16 + 4 * fq + j;
                        const bool valid = (keycol >= wst) && (keycol < wst + 16);
                        const int cidx = min(max(keycol - qcol + 15, 0), 30);
                        const float sv = valid ? s2[cblk][j] + rb[ridx * 31 + cidx] : -1.0e30f;
                        s2[cblk][j] = sv; ml2 = fmaxf(ml2, sv);
                    }
                ml2 = fmaxf(ml2, shx(ml2, 16)); ml2 = fmaxf(ml2, shx(ml2, 32));
                const float mn = fmaxf(mrun, ml2), sc = __builtin_amdgcn_exp2f((mrun - mn) * 1.44269504f); mrun = mn; lrun *= sc;
#pragma unroll
                for (int d = 0; d < 4; ++d) ot[d] = ot[d] * sc;
#pragma unroll
                for (int cblk = 0; cblk < 2; ++cblk)
#pragma unroll
                    for (int j = 0; j < 4; ++j) { const float pv = __builtin_amdgcn_exp2f((s2[cblk][j] - mrun) * 1.44269504f); s2[cblk][j] = pv; lrun += pv; }
                u32x4 pw; pw.x = cvtpk(s2[0][0], s2[0][1]); pw.y = cvtpk(s2[0][2], s2[0][3]); pw.z = cvtpk(s2[1][0], s2[1][1]); pw.w = cvtpk(s2[1][2], s2[1][3]);
                const bf16x8 pb = __builtin_bit_cast(bf16x8, pw);
                const LAS unsigned char* Vl = Kl + NA_KROW;
#pragma unroll
                for (int db = 0; db < 4; ++db) {
                    const LAS unsigned char* vrow = Vl + (db * 16 + fr) * 128 + (fq & 1) * 8;
                    const s16x4 lo = *(const LAS s16x4*)(vrow + ((ch ^ (fr & 7)) * 16)), hi = *(const LAS s16x4*)(vrow + (((ch + 2) ^ (fr & 7)) * 16));
                    ot[db] = MFMA16(__builtin_shufflevector(lo, hi, 0, 1, 2, 3, 4, 5, 6, 7), pb, ot[db]);
                }
            }
            if (kh == 1) {
                LAS float* mp = (LAS float*)(lds + NA_MRG_OFF) + (cb * 64 + lane) * 18;
                float l1 = lrun; l1 += shx(l1, 16); l1 += shx(l1, 32);
#pragma unroll
                for (int db = 0; db < 4; ++db) *(LAS f32x4*)(mp + 4 * db) = ot[db];
                mp[16] = mrun; mp[17] = l1;
            }
        }
#undef NA_ISSUE_ROW
    }
}

DI void ret_state_sweep(LAS unsigned char* lds, const bf16_t* MX, const bf16_t* VT, bf16_t* ST, int b, int hh, int dir, float lg, int wave) {
    const int qc = 256 * (hh >> 1) + 64 * (hh & 1);
    const size_t tok0 = (size_t)b * SEQ;
    const int lane = lane_id(), r = lane & 31, h = lane >> 5;
    const int dkg = wave & 3, dvh = wave >> 2;
    bf16x8 qf[8];
    { const int target = 32 * dkg + r;
#pragma unroll
      for (int s = 0; s < 8; ++s) { const bool hit = ((target >> 4) == s) && (((target >> 3) & 1) == h); const int j = target & 7;
        u32x4 w; w.x = (hit && (j >> 1) == 0) ? ((j & 1) ? 0x3F800000u : 0x00003F80u) : 0u; w.y = (hit && (j >> 1) == 1) ? ((j & 1) ? 0x3F800000u : 0x00003F80u) : 0u;
        w.z = (hit && (j >> 1) == 2) ? ((j & 1) ? 0x3F800000u : 0x00003F80u) : 0u; w.w = (hit && (j >> 1) == 3) ? ((j & 1) ? 0x3F800000u : 0x00003F80u) : 0u;
        qf[s] = __builtin_bit_cast(bf16x8, w); } }
    const bf16_t* Kb = MX + tok0 * MXW + C_RK + qc;
    const bf16_t* Vb = VT + (size_t)(hh * 256) * VTP + tok0;
#define SW_KT(i_) (4 * (dir ? 7 - ((i_) >> 2) : ((i_) >> 2)) + ((i_) & 3))
#define SW_ISSUE(i_, buf_) do { const int kt_ = SW_KT(i_); const int ln_ = lane_id(); \
        const char* Kt_ = (const char*)Kb + (size_t)kt_ * (64 * MXW * 2); const char* Vt_ = (const char*)Vb + (size_t)kt_ * 128; \
        _Pragma("unroll") for (int i2_ = 0; i2_ < 2; ++i2_) { const int key_ = 4 * (wave * 2 + i2_) + (ln_ >> 4), ck_ = (ln_ & 15) ^ (key_ & 15); \
            __builtin_amdgcn_global_load_lds((const unsigned*)(Kt_ + (unsigned)(key_ * MXW + (ck_ >> 3) * 128 + (ck_ & 7) * 8) * 2u), (LAS unsigned*)(lds + (buf_) * RBUF + (wave * 2 + i2_) * 1024), 16, 0, 0); } \
        _Pragma("unroll") for (int i2_ = 0; i2_ < 4; ++i2_) { const int dv_ = 8 * (wave * 4 + i2_) + (ln_ >> 3), c_ = (ln_ & 7) ^ ((dv_ >> 1) & 7); \
            __builtin_amdgcn_global_load_lds((const unsigned*)(Vt_ + (unsigned)(dv_ * VTP + c_ * 8) * 2u), (LAS unsigned*)(lds + (buf_) * RBUF + RK_BYTES + (wave * 4 + i2_) * 1024), 16, 0, 0); } } while (0)
    const int kA = r * 256 + 16 * (h ^ (r & 1)), sx32 = ((r & 15) >> 1) * 32;
    const int vA = r * 128 + dvh * (4 * 4096), mv16 = (((r >> 1) & 7) * 16) ^ (h * 16);
    const float g256 = __builtin_amdgcn_exp2f(lg * 256.0f);
    f32x16 z[4], R[4];
#pragma unroll
    for (int d = 0; d < 4; ++d)
#pragma unroll
        for (int i = 0; i < 16; ++i) { z[d][i] = 0.f; R[d][i] = 0.f; }
    SW_ISSUE(0, 0); SW_ISSUE(1, 1);
    int cur = 0, nx2 = 2;
#pragma unroll 1
    for (int it = 0; it < 32; ++it) {
        if (it + 1 < 32) asm volatile("s_waitcnt vmcnt(6)" ::: "memory");
        else asm volatile("s_waitcnt vmcnt(0)" ::: "memory");
        __builtin_amdgcn_s_barrier();
        asm volatile("" ::: "memory");
        if (it + 2 < 32) SW_ISSUE(it + 2, nx2);
        const LAS unsigned char* Kl = lds + cur * RBUF;
        const LAS unsigned char* Vl = Kl + RK_BYTES;
        const int kt = SW_KT(it), n = kt >> 2;
        const int tqf = dir ? 256 * n : 256 * n + 255;
        bf16x8 f4[4];
#pragma unroll
        for (int kb = 0; kb < 2; ++kb) {
            f32x16 x;
#pragma unroll
            for (int i = 0; i < 16; ++i) x[i] = 0.f;
            { bf16x8 af[8];
#pragma unroll
              for (int s = 0; s < 8; ++s) af[s] = *(const LAS bf16x8*)(Kl + kA + ((s * 32) ^ sx32) + kb * 8192);
#pragma unroll
              for (int s = 0; s < 8; ++s) x = MFMA32(af[s], qf[s], x); }
            __builtin_amdgcn_sched_barrier(0);
            const float d0 = dir ? (float)(kt * 64 + kb * 32 + 4 * h - tqf) : (float)(tqf - kt * 64 - kb * 32 - 4 * h);
#pragma unroll
            for (int i = 0; i < 16; ++i) { const float cr = (float)((i & 3) + 8 * (i >> 2)); x[i] *= __builtin_amdgcn_exp2f(lg * (dir ? d0 + cr : d0 - cr)); }
#pragma unroll
            for (int s2 = 0; s2 < 2; ++s2) {
                u32x4 pw; pw.x = cvtpk(x[8 * s2 + 0], x[8 * s2 + 1]); pw.y = cvtpk(x[8 * s2 + 2], x[8 * s2 + 3]); pw.z = cvtpk(x[8 * s2 + 4], x[8 * s2 + 5]); pw.w = cvtpk(x[8 * s2 + 6], x[8 * s2 + 7]);
                f4[2 * kb + s2] = __builtin_bit_cast(bf16x8, pw);
            }
            __builtin_amdgcn_sched_barrier(0);
        }
#pragma unroll
        for (int f = 0; f < 4; ++f) {
            const int vo = vA + ((f * 32) ^ mv16);
#pragma unroll
            for (int db = 0; db < 4; ++db) z[db] = MFMA32(f4[f], *(const LAS bf16x8*)(Vl + vo + db * 4096), z[db]);
            __builtin_amdgcn_sched_barrier(0);
        }
        if ((it & 3) == 3) {
            bf16_t* sp = ST + ((size_t)(((b * 4 + hh) * 8) + n) << 16) + (size_t)(dvh * 128 + r) * 256 + dir * 128 + 32 * dkg + 4 * h;
#pragma unroll
            for (int db = 0; db < 4; ++db) {
#pragma unroll
                for (int i = 0; i < 16; ++i) { R[db][i] = R[db][i] * g256 + z[db][i]; z[db][i] = 0.f; }
#pragma unroll
                for (int g = 0; g < 4; ++g) { u32x2 w; w.x = cvtpk(R[db][4 * g + 0], R[db][4 * g + 1]); w.y = cvtpk(R[db][4 * g + 2], R[db][4 * g + 3]);
                    *(u32x2*)(sp + (size_t)(db * 32) * 256 + 8 * g) = w; }
            }
        }
        cur = (cur == 2) ? 0 : cur + 1; nx2 = (nx2 == 2) ? 0 : nx2 + 1;
    }
#undef SW_ISSUE
#undef SW_KT
}
DI void mixer_states(LAS unsigned char* lds, int G, const int wave_s) {
    int wave = wave_s; asm volatile("" : "+s"(wave));
    bf16_t* MX = (bf16_t*)(PWS(lds) + OFF_MX); const bf16_t* VT = (const bf16_t*)(PWS(lds) + OFF_VT); bf16_t* ST = (bf16_t*)POUT(lds);
    const int vcu = (G % 8 == 0) ? (int)(blockIdx.x & 7) * (G / 8) + (int)(blockIdx.x >> 3) : (int)blockIdx.x;
    for (int u = vcu; u < BATCH * 4 * 2; u += G) {
        const int dir = u & 1, hh = (u >> 1) & 3, b = u >> 3;
        const float lg = -log1pf(__expf(-PIN(lds, dir ? 8 : 7)[hh])) * 1.44269504f;
        __syncthreads();
        ret_state_sweep(lds, MX, VT, ST, b, hh, dir, lg, wave);
    }
}
DI void mixer_phase(LAS unsigned char* lds, int G, const int wave_s) {
    int wave = wave_s; asm volatile("" : "+s"(wave));
    const int lane = lane_id(), tid = wave * 64 + lane;
    bf16_t* MX = (bf16_t*)(PWS(lds) + OFF_MX); const bf16_t* VT = (const bf16_t*)(PWS(lds) + OFF_VT); bf16_t* ST = (bf16_t*)POUT(lds);
    const int vcu = (G % 8 == 0) ? (int)(blockIdx.x & 7) * (G / 8) + (int)(blockIdx.x >> 3) : (int)blockIdx.x;
    for (int u = vcu; u < BATCH * 4 * 8; u += G) {
        const int qt = u & 7, hh = (u >> 3) & 3, b = u >> 5;
        const float ef = __expf(-PIN(lds, 7)[hh]), eb = __expf(-PIN(lds, 8)[hh]);
        const float lgf = -log1pf(ef) * 1.44269504f, nlgb = log1pf(eb) * 1.44269504f;
        __syncthreads();
        { const int t2 = wave * 64 + lane_id();
          if (t2 < 32) { const int i = t2 & 15; const float cr = (float)((i & 3) + 8 * (i >> 2));
            ((LAS float*)(lds + RTAB_OFF))[t2] = __builtin_amdgcn_exp2f(-(t2 < 16 ? lgf : nlgb) * cr); } }
        __syncthreads();
        ret_unit(lds, MX, VT, ST, b, hh, qt, lgf, nlgb, wave, 0);
    }
    __syncthreads();
    na_phase(lds, G, vcu, wave_s);
}

#define XB_TMO      128
#define XB_XCNT(j)  (256  + 64 * (j))
#define XB_XSUB(j)  (1280 + 64 * (j))
#define XB_XGEN(j)  (2304 + 64 * (j))
#define XB_TOP      3328
#define XB_TOPGEN   3392
#define XCD_BAR_WORDS 3456
#define XB_SPIN_CAP (1u << 18)

__device__ __forceinline__ unsigned xb_ld(unsigned* p)              { return __hip_atomic_load(p, __ATOMIC_RELAXED, __HIP_MEMORY_SCOPE_AGENT); }
__device__ __forceinline__ unsigned xb_add(unsigned* p, unsigned v) { return __hip_atomic_fetch_add(p, v, __ATOMIC_RELAXED, __HIP_MEMORY_SCOPE_AGENT); }
__device__ __forceinline__ unsigned xb_xcc_id() { return (unsigned)__builtin_amdgcn_s_getreg((3 << 11) | 20) & 0xFu; }
#define XB_SPIN(cond, bar) do { unsigned _sp = 0; while (cond) { __builtin_amdgcn_s_sleep(1); \
    if ((++_sp & 255u) == 0u) { if (xb_ld(&(bar)[XB_TMO])) break; if (_sp > XB_SPIN_CAP) { atomicAdd(&(bar)[XB_TMO], 1u); break; } } } } while (0)

struct XcdBarrier {
    unsigned* bar; unsigned x;
    volatile LAS unsigned* st;
};

__device__ __forceinline__ XcdBarrier xcd_barrier_post(unsigned* bar, volatile LAS unsigned* st, const bool t0) {
    XcdBarrier b; b.bar = bar; b.x = xb_xcc_id(); b.st = st;
    if (t0) (void)xb_add(&bar[XB_XCNT(b.x)], 1u);
    return b;
}
__device__ __forceinline__ void xcd_barrier_complete(unsigned* bar, unsigned x, unsigned& nloc, unsigned& nx) {
    const unsigned G = gridDim.x * gridDim.y * gridDim.z;
    unsigned sum, cnt, mine, sp = 0u;
    for (;;) {
        sum = 0u; cnt = 0u; mine = 0u;
#pragma unroll
        for (unsigned j = 0; j < 16; ++j) { const unsigned c = xb_ld(&bar[XB_XCNT(j)]); sum += c; cnt += (c > 0u) ? 1u : 0u; mine = (j == x) ? c : mine; }
        if (sum == G) break;
        __builtin_amdgcn_s_sleep(1);
        if ((++sp & 255u) == 0u) { if (xb_ld(&bar[XB_TMO])) break; if (sp > XB_SPIN_CAP) { atomicAdd(&bar[XB_TMO], 1u); break; } }
    }
    nloc = mine > 0u ? mine : 1u; nx = cnt > 0u ? cnt : 1u;
}

__device__ __forceinline__ void xcd_barrier(const XcdBarrier& b, const bool t0) {
    asm volatile("s_waitcnt vmcnt(0)" ::: "memory");
    __syncthreads();
    if (t0) {
        unsigned* bar = b.bar;
        __builtin_amdgcn_s_waitcnt(0);
        unsigned nloc = b.st[0], nx = b.st[1];
        if (nloc == 0u) { xcd_barrier_complete(bar, b.x, nloc, nx); b.st[0] = nloc; b.st[1] = nx; }
        const unsigned old = xb_add(&bar[XB_XSUB(b.x)], 1u);
        const unsigned gen = old / nloc;
        if (old + 1u == (gen + 1u) * nloc) {
            __builtin_amdgcn_fence(__ATOMIC_RELEASE, "agent");
            asm volatile("s_waitcnt vmcnt(0)" ::: "memory");
            const unsigned og = xb_add(&bar[XB_TOP], 1u);
            const unsigned tg = og / nx;
            if (og + 1u == (tg + 1u) * nx) xb_add(&bar[XB_TOPGEN], 1u);
            else XB_SPIN(xb_ld(&bar[XB_TOPGEN]) == tg, bar);
            __builtin_amdgcn_fence(__ATOMIC_ACQUIRE, "agent");
            xb_add(&bar[XB_XGEN(b.x)], 1u);
            asm volatile("s_waitcnt vmcnt(0)" ::: "memory");
        } else {
            XB_SPIN(xb_ld(&bar[XB_XGEN(b.x)]) == gen, bar);
            __builtin_amdgcn_fence(__ATOMIC_ACQUIRE, "agent");
            asm volatile("s_waitcnt vmcnt(0)" ::: "memory");
        }
    }
    __syncthreads();
}

__global__ void __launch_bounds__(512) mega(Params p) {
    extern __shared__ __attribute__((aligned(16))) unsigned char lds_raw[];
    LAS unsigned char* lds = (LAS unsigned char*)lds_raw;
    cg::grid_group grid = cg::this_grid();
    constexpr int G = GRID;
    const int wave_s = __builtin_amdgcn_readfirstlane((int)threadIdx.x >> 6);
    if (threadIdx.x == 0) { volatile LAS unsigned long long* pt = (volatile LAS unsigned long long*)(lds + PTAB_OFF);
        pt[0] = (unsigned long long)p.in[0]; pt[1] = (unsigned long long)p.in[1]; pt[2] = (unsigned long long)p.in[2]; pt[3] = (unsigned long long)p.in[3]; pt[4] = (unsigned long long)p.in[4]; pt[5] = (unsigned long long)p.in[5];
        pt[6] = (unsigned long long)p.in[6]; pt[7] = (unsigned long long)p.in[7]; pt[8] = (unsigned long long)p.in[8]; pt[9] = (unsigned long long)p.in[9]; pt[10] = (unsigned long long)p.in[10]; pt[11] = (unsigned long long)p.in[11];
        pt[12] = (unsigned long long)p.in[12]; pt[13] = (unsigned long long)p.in[13]; pt[14] = (unsigned long long)p.in[14]; pt[15] = (unsigned long long)p.in[15]; pt[16] = (unsigned long long)p.in[16]; pt[17] = (unsigned long long)p.in[17];
        pt[18] = (unsigned long long)p.out; pt[19] = (unsigned long long)p.ws; }
    volatile LAS unsigned* bst = (volatile LAS unsigned*)(lds + LDS_BYTES - 16);
    if (threadIdx.x < 2) bst[threadIdx.x] = 0u;
    __syncthreads();
    XcdBarrier xbar = xcd_barrier_post((unsigned*)(PWS(lds) + OFF_BAR), bst, threadIdx.x == 0);
#pragma unroll 1
    for (int step = 0; step < 13; ++step) {
        const int ph = (step <= 4) ? step : (step == 5 ? 50 : step - 1);
        unsigned char* ws = PWS(lds);
        bf16_t* XB = (bf16_t*)(ws + OFF_XB); bf16_t* MX = (bf16_t*)(ws + OFF_MX); bf16_t* VT = (bf16_t*)(ws + OFF_VT);
        bf16_t* HB = (bf16_t*)(ws + OFF_H); bf16_t* HOUT = (bf16_t*)(ws + OFF_HOUT);
        float* rs = (float*)(ws + OFF_RS);
#if REP_MASK
      for (int rep = 0; rep <= ((REP_MASK >> ph) & 1); ++rep) {
#endif
        if (ph == 0) {
            prologue(lds, G, wave_s);
        } else if (ph == 3 || ph == 8 || ph == 11) {
            continue;
        } else if (ph == 2 || ph == 7 || ph == 10) {
            pg8::Gemm g; pg8::EpiRes E;
            const int fz = (ph == 2) ? 0 : (ph == 7 ? 1 : 2);
            if (ph == 7) g = pg8::Gemm{VT, (const bf16_t*)(ws + OFF_W_MIXO), D, D, M, D, D};
            else g = pg8::Gemm{HB, (const bf16_t*)(ws + (ph == 2 ? OFF_W_F1OUT : OFF_W_F2OUT)), DFF, DFF, M, D, DFF};
            E.xin32 = nullptr;   E.xinb = XB; E.xout = POUT(lds); E.gpost = PIN(lds, ph == 2 ? 4 : (ph == 7 ? 13 : 17)); E.halfstep = (ph == 7) ? 0 : 1;
            E.xb = XB; E.ssn = rs + (size_t)(fz + 1) * M; E.last = (ph == 10) ? 1 : 0; E.xl = lds + 131072;
            E.st1.xbuf = (unsigned*)(ws + OFF_XBUF); E.st1.cnt = (unsigned*)(ws + OFF_XCNT + (size_t)fz * XCNT_BANK);
            pg8::StaticOrder SO; SO.init(M, D, G, (int)blockIdx.x);
            SO.rev = (ph != 7) ? 1 : 0;
            pg8::gemm_phase<pg8::EpiRes, pg8::StaticOrder, true, true>(lds, g, SO, E, wave_s);
        } else if (ph == 50) {
            mixer_states(lds, G, wave_s);
        } else if (ph == 5) {
            mixer_phase(lds, G, wave_s);
        } else {
            const int njobs = (ph == 4 || ph == 6) ? 2 : 1;
#pragma unroll 1
            for (int j = 0; j < njobs; ++j) {
                pg8::Gemm g; pg8::Epi E; E.rs = rs + (size_t)(ph == 1 ? 0 : (ph == 4 ? 1 : 2)) * M; E.cs = (const float*)(ws + OFF_COS); E.sn = (const float*)(ws + OFF_SIN); E.gate = nullptr; E.ldg = MXW;
                if (ph == 1 || ph == 9) { g = pg8::Gemm{XB, (const bf16_t*)(ws + (ph == 1 ? OFF_W_F1IN : OFF_W_F2IN)), D, D, M, 2 * DFF, D}; E.mode = pg8::M_SWIGLU; E.O = HB; E.ldc = DFF; }
                else if (ph == 2 || ph == 10) { g = pg8::Gemm{HB, (const bf16_t*)(ws + (ph == 2 ? OFF_W_F1OUT : OFF_W_F2OUT)), DFF, DFF, M, D, DFF}; E.mode = pg8::M_STORE; E.O = HOUT; E.ldc = D; }
                else if (ph == 4) {
                    if (j == 0) { g = pg8::Gemm{XB, (const bf16_t*)(ws + OFF_W_MIXM), D, D, M, MXW, D}; E.mode = pg8::M_MIX; E.O = MX; E.ldc = MXW; }
                    else { g = pg8::Gemm{(const bf16_t*)(ws + OFF_W_VT), XB, D, D, VTROWS, M, D}; E.mode = pg8::M_VT; E.O = VT; E.ldc = VTP; }
                } else if (ph == 6) {
                    if (j == 0) { g = pg8::Gemm{MX + C_RG, (const bf16_t*)(ws + OFF_W_RETO), MXW, D, M, D, D}; E.mode = pg8::M_RETOUT; E.O = VT; E.ldc = D; E.gate = MX + C_GR; }
                    else { g = pg8::Gemm{MX + C_NQ, (const bf16_t*)(ws + OFF_W_NAO), MXW, 512, M, D, 512}; E.mode = pg8::M_NAOUT; E.O = VT; E.ldc = D; E.gate = MX + C_GN; }
                } else { g = pg8::Gemm{XB, (const bf16_t*)(ws + OFF_W_MIXO), D, D, M, D, D}; E.mode = pg8::M_STORE; E.O = VT; E.ldc = D; }
                pg8::StaticOrder S; S.init(g.M, g.N, G, (int)blockIdx.x);
                pg8::gemm_phase<pg8::Epi, pg8::StaticOrder, true, true>(lds, g, S, E, wave_s);
            }
        }
        if (gridDim.x == 0x7fffffffu) grid.sync();
        if (ph < 10 || ph >= 50) xcd_barrier(xbar, wave_s == 0 && lane_id() == 0);
#if EXTRA_SYNCS
        if (ph == 0) { for (int e = 0; e < EXTRA_SYNCS; ++e) xcd_barrier(xbar, wave_s == 0 && lane_id() == 0); }
#endif
#if REP_MASK
      }
#endif
    }
}

extern "C" void kernel_launch(void* const* d_in, const int* in_sizes, int n_in, void* d_out, int out_size, void* d_ws, size_t ws_size, hipStream_t stream) {
    static int grid = 0;
    if (grid == 0) {
        if (n_in != 18 || out_size != M * D || ws_size < WS_END) { fprintf(stderr, "kernel_launch: unexpected problem (n_in %d out %d ws %zu, need %zu)\n", n_in, out_size, ws_size, (size_t)WS_END); grid = -1; return; }
        int dev = 0, cus = 0, per_cu = 0;
        if (hipGetDevice(&dev) != hipSuccess || hipDeviceGetAttribute(&cus, hipDeviceAttributeMultiprocessorCount, dev) != hipSuccess) { grid = -1; return; }
        if (hipFuncSetAttribute((const void*)mega, hipFuncAttributeMaxDynamicSharedMemorySize, LDS_BYTES) != hipSuccess) { fprintf(stderr, "kernel_launch: hipFuncSetAttribute failed\n"); grid = -1; return; }
        if (hipOccupancyMaxActiveBlocksPerMultiprocessor(&per_cu, (const void*)mega, 512, LDS_BYTES) != hipSuccess || per_cu < 1) { fprintf(stderr, "kernel_launch: occupancy query says %d\n", per_cu); (void)hipGetLastError(); }
        if (cus < GRID) { fprintf(stderr, "kernel_launch: built for a %d-CU device, found %d CUs; nothing launched\n", GRID, cus); grid = -1; return; }
        grid = GRID;
    }
    if (grid < 0) return;
    Params p{};
    for (int i = 0; i < 18; ++i) p.in[i] = (const float*)d_in[i];
    p.out = (float*)d_out; p.ws = (unsigned char*)d_ws;
    void* args[] = {&p};
    if (hipMemsetAsync((char*)d_ws + OFF_BAR, 0, 16384, stream) != hipSuccess) { fprintf(stderr, "kernel_launch: hipMemsetAsync of the barrier words failed; nothing launched\n"); return; }
    hipError_t e = hipLaunchCooperativeKernel((const void*)mega, dim3(grid), dim3(512), args, LDS_BYTES, stream);
    if (e != hipSuccess) fprintf(stderr, "cooperative launch failed: %s (grid %d)\n", hipGetErrorString(e), grid);
}
```

```cpp
#include <hip/hip_runtime.h>
#include <hip/hip_cooperative_groups.h>
#include <cstdio>
#include <cstdint>
namespace cg = cooperative_groups;
__device__ __forceinline__ float shx(float v, int mask) {
    int l; asm volatile("v_mbcnt_lo_u32_b32 %0, -1, 0\n\tv_mbcnt_hi_u32_b32 %0, -1, %0" : "=v"(l));
    return __builtin_bit_cast(float, __builtin_amdgcn_ds_bpermute((l ^ mask) << 2, __builtin_bit_cast(int, v)));
}
namespace pg8 {
#define PG8_LAS __attribute__((address_space(3)))
typedef unsigned short bf16_t;
typedef short bf16x8 __attribute__((ext_vector_type(8)));
typedef float f32x4 __attribute__((ext_vector_type(4)));
typedef unsigned u32x4 __attribute__((ext_vector_type(4)));
constexpr int BM = 256, BK = 64, HALF = 128, HTB = HALF * BK * 2  , STAGE_BYTES = 8 * HTB, NXCD = 8, WGM = 8;

__host__ __device__ __forceinline__ int lds_byte(int r, int c) { const int st = (r >> 4) * 2 + (c >> 5), rr = r & 15, cc = c & 31, ob = rr * 64 + cc * 2; return st * 1024 + (ob ^ (((ob >> 9) & 1) << 5)); }
__host__ __device__ __forceinline__ void stage_rc(int b, int& R, int& C) { const int st = b / 1024, sb = b % 1024, swz = sb ^ (((sb >> 9) & 1) << 5); R = (st >> 1) * 16 + swz / 64; C = (st & 1) * 32 + (swz % 64) / 2; }
__host__ __device__ __forceinline__ int perm32(int rho) { const int n = rho >> 4, i = rho & 15; return 8 * (i >> 2) + 4 * n + (i & 3); }

struct Unit { int pm, pn; };
struct Gemm { const bf16_t* A; const bf16_t* Bt; int lda, ldb, M, N, K; };

struct StaticOrder {
    int nM, nN, nwg, G, c, rev;
    __host__ __device__ void init(int M, int N, int G_, int c_) { nM = M / BM; nN = N / BM; nwg = nM * nN; G = G_; c = c_; rev = 0; }
    __host__ __device__ bool next(int i, Unit& u) const {
        const long L = (long)i * G + c; if (L >= nwg) return false;
        int wgid = (int)L; { const int q = nwg / NXCD, r = nwg % NXCD, xcd = wgid % NXCD, off = wgid / NXCD; wgid = (xcd < r ? xcd * (q + 1) : r * (q + 1) + (xcd - r) * q) + off; }
        const int nig = WGM * nN, gid = wgid / nig, fm = gid * WGM, gsz = (nM - fm) < WGM ? (nM - fm) : WGM;
        u.pm = fm + ((wgid % nig) % gsz); u.pn = (wgid % nig) / gsz; if (rev) u.pm = nM - 1 - u.pm; return true;
    }
    __device__ __forceinline__ void a_ready(const Unit&) const {}
    __device__ __forceinline__ void done(const Unit&) const {}
};


typedef float f32x2_t __attribute__((ext_vector_type(2)));
typedef __bf16 bf16x2_t __attribute__((ext_vector_type(2)));
__device__ __forceinline__ unsigned cvtpk(float lo, float hi) { f32x2_t v = {lo, hi}; bf16x2_t b = __builtin_convertvector(v, bf16x2_t); return __builtin_bit_cast(unsigned, b); }
__device__ __forceinline__ float bf_lo(unsigned w) { return __uint_as_float(w << 16); }
__device__ __forceinline__ float bf_hi(unsigned w) { return __uint_as_float(w & 0xffff0000u); }
__device__ __forceinline__ float sigm_f(float v) { return __builtin_amdgcn_rcpf(1.0f + __builtin_amdgcn_exp2f(-1.44269504f * v)); }
__device__ __forceinline__ float silu_f(float v) { return v * sigm_f(v); }
__device__ __forceinline__ void store8(bf16_t* p, const f32x4 a, const f32x4 b) {
    u32x4 w; w.x = cvtpk(a[0], a[1]); w.y = cvtpk(a[2], a[3]); w.z = cvtpk(b[0], b[1]); w.w = cvtpk(b[2], b[3]); *(u32x4*)p = w;
}
typedef unsigned u32x2 __attribute__((ext_vector_type(2)));
enum EpiMode { M_STORE = 0, M_SWIGLU = 1, M_MIX = 2, M_VT = 3, M_RETOUT = 4, M_NAOUT = 5 };
struct Epi {
    static constexpr bool PERM = true, AFTER_DRAIN = false;
    int mode; bf16_t* O; int ldc; const float* rs; const float* cs; const float* sn; const bf16_t* gate; int ldg;
    __device__ __forceinline__ void operator()(const f32x4 (&acc)[2][2][4][2], const Unit& u, int wr, int wc, int fr, int fq) const {
        const int row0 = u.pm * BM + wr * 64 + fr;
        const int cw = wc * 32 + 8 * fq;
        if (mode == M_STORE) {
#pragma unroll
            for (int ai = 0; ai < 2; ++ai)
#pragma unroll
                for (int m = 0; m < 4; ++m) { bf16_t* rowp = O + (size_t)(row0 + ai * HALF + m * 16) * ldc + u.pn * BM + cw;
#pragma unroll
                    for (int bj = 0; bj < 2; ++bj) store8(rowp + bj * HALF, acc[ai][bj][m][0], acc[ai][bj][m][1]); }
        } else if (mode == M_SWIGLU) {
#pragma unroll
            for (int ai = 0; ai < 2; ++ai)
#pragma unroll
                for (int m = 0; m < 4; ++m) { const int row = row0 + ai * HALF + m * 16; const float rsv = __builtin_amdgcn_rsqf(rs[row] * (1.0f / 1024.0f) + 1e-6f);
                    f32x4 h0, h1;
#pragma unroll
                    for (int e = 0; e < 4; ++e) { h0[e] = silu_f(acc[ai][0][m][0][e] * rsv) * (acc[ai][1][m][0][e] * rsv); h1[e] = silu_f(acc[ai][0][m][1][e] * rsv) * (acc[ai][1][m][1][e] * rsv); }
                    store8(O + (size_t)row * ldc + u.pn * HALF + cw, h0, h1); }
        } else if (mode == M_MIX) {
            const int sub = u.pn < 4 ? 0 : (u.pn < 8 ? 1 : (u.pn < 12 ? 2 : 3));
            if (sub == 0) {
                const int i0 = 32 * (wc & 1) + 8 * fq;
#pragma unroll
                for (int ai = 0; ai < 2; ++ai)
#pragma unroll
                    for (int m = 0; m < 4; ++m) { const int row = row0 + ai * HALF + m * 16; const float rsv = __builtin_amdgcn_rsqf(rs[row] * (1.0f / 1024.0f) + 1e-6f); const int pos = row & 2047;
                        const f32x4 c0 = *(const f32x4*)(cs + pos * 64 + i0), c1 = *(const f32x4*)(cs + pos * 64 + i0 + 4);
                        const f32x4 s0 = *(const f32x4*)(sn + pos * 64 + i0), s1 = *(const f32x4*)(sn + pos * 64 + i0 + 4);
                        const f32x4 x1a = acc[ai][0][m][0] * rsv, x1b = acc[ai][0][m][1] * rsv, x2a = acc[ai][1][m][0] * rsv, x2b = acc[ai][1][m][1] * rsv;
                        bf16_t* rowp = O + (size_t)row * ldc + u.pn * BM + cw;
                        store8(rowp, x1a * c0 - x2a * s0, x1b * c1 - x2b * s1);
                        store8(rowp + HALF, x1a * s0 + x2a * c0, x1b * s1 + x2b * c1); }
            } else {
#pragma unroll
                for (int ai = 0; ai < 2; ++ai)
#pragma unroll
                    for (int m = 0; m < 4; ++m) { const int row = row0 + ai * HALF + m * 16; const float rsv = __builtin_amdgcn_rsqf(rs[row] * (1.0f / 1024.0f) + 1e-6f);
                        bf16_t* rowp = O + (size_t)row * ldc + u.pn * BM + cw;
#pragma unroll
                        for (int bj = 0; bj < 2; ++bj) { f32x4 v0 = acc[ai][bj][m][0] * rsv, v1 = acc[ai][bj][m][1] * rsv;
                            if (sub == 1) {
#pragma unroll
                                for (int e = 0; e < 4; ++e) { v0[e] = silu_f(v0[e]); v1[e] = silu_f(v1[e]); } }
                            else if (sub == 3) {
#pragma unroll
                                for (int e = 0; e < 4; ++e) { v0[e] = sigm_f(v0[e]); v1[e] = sigm_f(v1[e]); } }
                            store8(rowp + bj * HALF, v0, v1); } }
            }
        } else if (mode == M_VT) {
            f32x4 cv[2][2];
#pragma unroll
            for (int bj = 0; bj < 2; ++bj)
#pragma unroll
                for (int n = 0; n < 2; ++n) { const f32x4 sv = *(const f32x4*)(rs + u.pn * BM + bj * HALF + cw + 4 * n);
#pragma unroll
                    for (int e = 0; e < 4; ++e) cv[bj][n][e] = __builtin_amdgcn_rsqf(sv[e] * (1.0f / 1024.0f) + 1e-6f); }
#pragma unroll
            for (int ai = 0; ai < 2; ++ai)
#pragma unroll
                for (int m = 0; m < 4; ++m) { bf16_t* rowp = O + (size_t)(row0 + ai * HALF + m * 16) * ldc + u.pn * BM + cw;
#pragma unroll
                    for (int bj = 0; bj < 2; ++bj) {
                        if (u.pm < 4) {
                            const f32x4 v0 = acc[ai][bj][m][0] * cv[bj][0], v1 = acc[ai][bj][m][1] * cv[bj][1];
                            bf16_t* gb = rowp + bj * HALF - 8 * (fq & 1) + 4 * (fq & 1);
                            u32x2 w0, w1; w0.x = cvtpk(v0[0], v0[1]); w0.y = cvtpk(v0[2], v0[3]); w1.x = cvtpk(v1[0], v1[1]); w1.y = cvtpk(v1[2], v1[3]);
                            *(u32x2*)gb = w0; *(u32x2*)(gb + 8) = w1;
                        } else store8(rowp + bj * HALF, acc[ai][bj][m][0] * cv[bj][0], acc[ai][bj][m][1] * cv[bj][1]); } }
        } else {
#pragma unroll
            for (int ai = 0; ai < 2; ++ai)
#pragma unroll
                for (int m = 0; m < 4; ++m) { const int row = row0 + ai * HALF + m * 16;
                    bf16_t* rowp = O + (size_t)row * ldc + u.pn * BM + cw; const bf16_t* gp = gate + (size_t)row * ldg + u.pn * BM + cw;
#pragma unroll
                    for (int bj = 0; bj < 2; ++bj) { const u32x4 gw = *(const u32x4*)(gp + bj * HALF);
                        f32x4 v0 = acc[ai][bj][m][0], v1 = acc[ai][bj][m][1];
                        v0[0] *= bf_lo(gw.x); v0[1] *= bf_hi(gw.x); v0[2] *= bf_lo(gw.y); v0[3] *= bf_hi(gw.y);
                        v1[0] *= bf_lo(gw.z); v1[1] *= bf_hi(gw.z); v1[2] *= bf_lo(gw.w); v1[3] *= bf_hi(gw.w);
                        if (mode == M_NAOUT) { const u32x4 pw = *(const u32x4*)(rowp + bj * HALF);
                            v0[0] += bf_lo(pw.x); v0[1] += bf_hi(pw.x); v0[2] += bf_lo(pw.y); v0[3] += bf_hi(pw.y);
                            v1[0] += bf_lo(pw.z); v1[1] += bf_hi(pw.z); v1[2] += bf_lo(pw.w); v1[3] += bf_hi(pw.w); }
                        store8(rowp + bj * HALF, v0, v1); } }
        }
    }
};

struct PanelRms {
    unsigned* xbuf;
    unsigned* cnt;
    __device__ __forceinline__ void publish(const f32x4 (&v)[2][2][4][2], const Unit& u, int wr, int wc, int fr, int fq, PG8_LAS unsigned char* lds, int wid, int lane) const {
        PG8_LAS float* P = (PG8_LAS float*)lds;
        PG8_LAS float* S = (PG8_LAS float*)(lds + 4096);
#pragma unroll
        for (int ai = 0; ai < 2; ++ai)
#pragma unroll
            for (int m = 0; m < 4; ++m) {
                float s = 0.f;
#pragma unroll
                for (int bj = 0; bj < 2; ++bj)
#pragma unroll
                    for (int n = 0; n < 2; ++n) { const f32x4 x = v[ai][bj][m][n]; s += (x[0] * x[0] + x[1] * x[1]) + (x[2] * x[2] + x[3] * x[3]); }
                s += shx(s, 16); s += shx(s, 32);
                if (fq == 0) P[(ai * HALF + wr * 64 + m * 16 + fr) * 4 + wc] = s;
            }
        asm volatile("s_waitcnt lgkmcnt(0)" ::: "memory"); __builtin_amdgcn_s_barrier(); asm volatile("" ::: "memory");
        const int row = wid * 32 + (lane & 31);
        if (lane < 32) {
            const float t = (P[row * 4 + 0] + P[row * 4 + 1]) + (P[row * 4 + 2] + P[row * 4 + 3]);
            __hip_atomic_store(xbuf + ((size_t)(u.pm * BM + row) * 4 + u.pn), __float_as_uint(t), __ATOMIC_RELAXED, __HIP_MEMORY_SCOPE_AGENT);
        }
        asm volatile("s_waitcnt vmcnt(0)" ::: "memory");
        if (lane == 0) __hip_atomic_fetch_add(cnt + 64 * u.pm, 1u, __ATOMIC_RELAXED, __HIP_MEMORY_SCOPE_AGENT);
    }
    __device__ __forceinline__ void finish(const Unit& u, PG8_LAS unsigned char* lds, int wid, int lane) const {
        PG8_LAS float* S = (PG8_LAS float*)(lds + 4096);
        const int row = wid * 32 + (lane & 31);
        if (wid == 0) {
            unsigned sp = 0;
            while ((unsigned)__builtin_amdgcn_readfirstlane(__hip_atomic_load(cnt + 64 * u.pm, __ATOMIC_RELAXED, __HIP_MEMORY_SCOPE_AGENT)) < 32u) { __builtin_amdgcn_s_sleep(2); if (++sp > (1u << 22)) break; }
            __builtin_amdgcn_fence(__ATOMIC_ACQUIRE, "agent");
        }
        asm volatile("s_waitcnt vmcnt(0) lgkmcnt(0)" ::: "memory"); __builtin_amdgcn_s_barrier(); asm volatile("" ::: "memory");
        if (lane < 32) {
            const unsigned* slot = xbuf + (size_t)(u.pm * BM + row) * 4; float t = 0.f;
#pragma unroll
            for (int k = 0; k < 4; ++k) t += __uint_as_float(__hip_atomic_load(slot + k, __ATOMIC_RELAXED, __HIP_MEMORY_SCOPE_AGENT));
            S[row] = 1.0f / sqrtf(t * (1.0f / 1024.0f) + 1e-6f);
        }
        asm volatile("s_waitcnt lgkmcnt(0)" ::: "memory"); __builtin_amdgcn_s_barrier(); asm volatile("" ::: "memory");
    }
};
struct EpiRes {
    static constexpr bool PERM = true, AFTER_DRAIN = false;
    const float* xin32; const bf16_t* xinb; float* xout; const float* gpost; int halfstep; bf16_t* xb; float* ssn; int last; PanelRms st1; PG8_LAS unsigned char* xl;
    __device__ __forceinline__ void operator()(f32x4 (&acc)[2][2][4][2], const Unit& u, int wr, int wc, int fr_, int fq_) const {
        int lane; asm volatile("v_mbcnt_lo_u32_b32 %0, -1, 0\n\tv_mbcnt_hi_u32_b32 %0, -1, %0" : "=v"(lane));
        const int fr = lane & 15, fq = lane >> 4, wid = wr * 4 + wc; (void)fr_; (void)fq_;
        PG8_LAS float* P = (PG8_LAS float*)xl;
        const PG8_LAS float* S = (const PG8_LAS float*)(xl + 4096);
        const int col0 = u.pn * BM + wc * 32 + 8 * fq;
        st1.publish(acc, u, wr, wc, fr, fq, xl, wid, lane);
        u32x4 xw[2][4][2];
        if (!xin32) {
#pragma unroll
            for (int ai = 0; ai < 2; ++ai)
#pragma unroll
                for (int m = 0; m < 4; ++m)
#pragma unroll
                    for (int bj = 0; bj < 2; ++bj) xw[ai][m][bj] = *(const u32x4*)(xinb + (size_t)(u.pm * BM + ai * HALF + wr * 64 + m * 16 + fr) * 1024 + col0 + bj * HALF);
        }
        st1.finish(u, xl, wid, lane);
        const float cmul = halfstep ? 0.5f : 1.0f;
        f32x4 gv[2][2];
#pragma unroll
        for (int bj = 0; bj < 2; ++bj)
#pragma unroll
            for (int n = 0; n < 2; ++n) gv[bj][n] = *(const f32x4*)(gpost + col0 + bj * HALF + 4 * n) * cmul;
#pragma unroll
        for (int ai = 0; ai < 2; ++ai)
#pragma unroll
            for (int m = 0; m < 4; ++m) { const int r = ai * HALF + wr * 64 + m * 16 + fr; const float nh = S[r]; const size_t off = (size_t)(u.pm * BM + r) * 1024 + col0;
                float s2 = 0.f;
#pragma unroll
                for (int bj = 0; bj < 2; ++bj) { f32x4 x1[2], xo[2];
                    if (xin32) { xo[0] = *(const f32x4*)(xin32 + off + bj * HALF); xo[1] = *(const f32x4*)(xin32 + off + bj * HALF + 4); }
                    else { const u32x4 w = xw[ai][m][bj]; xo[0] = (f32x4){bf_lo(w.x), bf_hi(w.x), bf_lo(w.y), bf_hi(w.y)}; xo[1] = (f32x4){bf_lo(w.z), bf_hi(w.z), bf_lo(w.w), bf_hi(w.w)}; }
#pragma unroll
                    for (int n = 0; n < 2; ++n) { x1[n] = xo[n] + gv[bj][n] * acc[ai][bj][m][n] * nh;
                        s2 += (x1[n][0] * x1[n][0] + x1[n][1] * x1[n][1]) + (x1[n][2] * x1[n][2] + x1[n][3] * x1[n][3]); }
                    if (!last) store8(xb + off + bj * HALF, x1[0], x1[1]);
                    else { *(f32x4*)(xout + off + bj * HALF) = x1[0]; *(f32x4*)(xout + off + bj * HALF + 4) = x1[1]; } }
                if (!last) { s2 += shx(s2, 16); s2 += shx(s2, 32); if (fq == 0) P[r * 4 + wc] = s2; }
                if (m & 1) asm volatile("" ::: "memory"); }
        if (last) return;
        asm volatile("s_waitcnt lgkmcnt(0)" ::: "memory"); __builtin_amdgcn_s_barrier(); asm volatile("" ::: "memory");
        if (lane < 32) { const int row = wid * 32 + lane; const float t = (P[row * 4 + 0] + P[row * 4 + 1]) + (P[row * 4 + 2] + P[row * 4 + 3]);
            __hip_atomic_fetch_add(ssn + u.pm * BM + row, t, __ATOMIC_RELAXED, __HIP_MEMORY_SCOPE_AGENT); }
    }
};
struct OneUnit { Unit u;
    __host__ __device__ bool next(int i, Unit& o) const { if (i != 0) return false; o = u; return true; }
    __device__ __forceinline__ void a_ready(const Unit&) const {}
    __device__ __forceinline__ void done(const Unit&) const {}
};

template <class Epi, class Sched, bool ALIGN_EPI = false, bool SP2 = false>
__device__ __forceinline__ void gemm_phase(PG8_LAS unsigned char* lds, const Gemm g, const Sched& S, const Epi& E, const int wid_) {
    int wid = wid_; asm volatile("" : "+s"(wid)); int lane; asm volatile("v_mbcnt_lo_u32_b32 %0, -1, 0\n\tv_mbcnt_hi_u32_b32 %0, -1, %0" : "=v"(lane)); const int tid = wid * 64 + lane, wr = wid >> 2, wc = wid & 3, fr = lane & 15, fq = lane >> 4;
    const int K = g.K, nt = K / BK;
    unsigned voffA[2], voffB[2];
#pragma unroll
    for (int i = 0; i < 2; ++i) { int R, C; stage_rc(tid * 16 + i * 8192, R, C); const int Rb = Epi::PERM ? ((R & ~31) + perm32(R & 31)) : R;
        voffA[i] = (unsigned)(R * g.lda + C) * 2u; voffB[i] = (unsigned)(Rb * g.ldb + C) * 2u; }
    const size_t kstep = (size_t)(BK * 2);
    const size_t hstepA = (size_t)HALF * g.lda * 2, hstepB = (size_t)HALF * g.ldb * 2;
    const size_t tstepA = 2 * hstepA, tstepB = 2 * hstepB;
    const unsigned ldsw = (unsigned)wid * 1024u;
    const int aoff = lds_byte(wr * 64 + fr, fq * 8), boff = lds_byte(wc * 32 + fr, fq * 8);
#define PG8_SA(b, h) (((b) * 2 + (h)) * HTB)
#define PG8_SB(b, h) ((4 + (b) * 2 + (h)) * HTB)
#define PG8_STAGE(bufoff, gbase, voff) do { _Pragma("unroll") for (int _i = 0; _i < 2; ++_i) \
        __builtin_amdgcn_global_load_lds((const unsigned*)((const char*)(gbase) + (voff)[_i]), (PG8_LAS unsigned*)(lds + (bufoff) + ldsw + _i * 8192), 16, 0, 0); } while (0)
#define PG8_LDA(dst, b, h) do { _Pragma("unroll") for (int m = 0; m < 4; ++m) _Pragma("unroll") for (int k = 0; k < 2; ++k) dst[m][k] = *(const PG8_LAS bf16x8*)(lds + PG8_SA(b, h) + aoff + m * 2048 + k * 1024); } while (0)
#define PG8_LDB(dst, b, h) do { _Pragma("unroll") for (int n = 0; n < 2; ++n) _Pragma("unroll") for (int k = 0; k < 2; ++k) dst[n][k] = *(const PG8_LAS bf16x8*)(lds + PG8_SB(b, h) + boff + n * 2048 + k * 1024); } while (0)
#define PG8_MMA(ai, bj, At, Bt) do { __builtin_amdgcn_s_setprio(1); _Pragma("unroll") for (int m = 0; m < 4; ++m) _Pragma("unroll") for (int n = 0; n < 2; ++n) _Pragma("unroll") for (int k = 0; k < 2; ++k) \
        acc[ai][bj][m][n] = __builtin_amdgcn_mfma_f32_16x16x32_bf16(Bt[n][k], At[m][k], acc[ai][bj][m][n], 0, 0, 0); __builtin_amdgcn_s_setprio(0); } while (0)
#define PG8_WAIT_V(n) asm volatile("s_waitcnt vmcnt(" #n ")" ::: "memory")
#define PG8_WAIT_L(n) asm volatile("s_waitcnt lgkmcnt(" #n ")" ::: "memory")
#define PG8_BAR __builtin_amdgcn_s_barrier()
#define PG8_SCHED __builtin_amdgcn_sched_barrier(0)
    Unit cur, nxt; int ui = 0;
    if (!S.next(0, cur)) return;
    f32x4 acc[2][2][4][2];
#pragma unroll
    for (int a = 0; a < 2; ++a)
#pragma unroll
        for (int b = 0; b < 2; ++b)
#pragma unroll
            for (int m = 0; m < 4; ++m)
#pragma unroll
                for (int n = 0; n < 2; ++n) acc[a][b][m][n] = (f32x4){0.f, 0.f, 0.f, 0.f};
    bf16x8 At[4][2], B0[2][2], B1[2][2];
    const char* cA = (const char*)g.A + (size_t)cur.pm * tstepA; const char* cB = (const char*)g.Bt + (size_t)cur.pn * tstepB;
    S.a_ready(cur);
    if constexpr (SP2) {
        PG8_STAGE(PG8_SB(0, 0), cB, voffB); PG8_STAGE(PG8_SB(0, 1), cB + hstepB, voffB); PG8_STAGE(PG8_SA(0, 0), cA, voffA); PG8_STAGE(PG8_SA(0, 1), cA + hstepA, voffA);
        if (wr == 1) PG8_BAR;
        PG8_WAIT_V(2); PG8_BAR;
        PG8_STAGE(PG8_SB(1, 0), cB + kstep, voffB); PG8_STAGE(PG8_SA(1, 0), cA + kstep, voffA); PG8_STAGE(PG8_SB(1, 1), cB + hstepB + kstep, voffB);
        PG8_WAIT_V(6); PG8_BAR;
    } else {
        PG8_STAGE(PG8_SB(0, 0), cB, voffB); PG8_STAGE(PG8_SA(0, 0), cA, voffA); PG8_STAGE(PG8_SB(0, 1), cB + hstepB, voffB); PG8_STAGE(PG8_SA(0, 1), cA + hstepA, voffA);
        if (wr == 1) PG8_BAR;
        PG8_WAIT_V(4); PG8_BAR;
        PG8_STAGE(PG8_SB(1, 0), cB + kstep, voffB); PG8_STAGE(PG8_SA(1, 0), cA + kstep, voffA); PG8_STAGE(PG8_SB(1, 1), cB + hstepB + kstep, voffB);
        PG8_WAIT_V(6); PG8_BAR;
    }
    for (;;) {
        const bool has_next = S.next(ui + 1, nxt);
        const char* nA = has_next ? (const char*)g.A + (size_t)nxt.pm * tstepA : cA; const char* nB = has_next ? (const char*)g.Bt + (size_t)nxt.pn * tstepB : cB;
        for (int t = 0; t < nt; t += 2) {
            const bool last = (t == nt - 2);
            const char* a1 = cA + (size_t)(t + 1) * kstep;
            const char* a2 = last ? nA : cA + (size_t)(t + 2) * kstep; const char* b2 = last ? nB : cB + (size_t)(t + 2) * kstep;
            const char* a3 = a2 + kstep; const char* b3 = b2 + kstep;
            if (last && has_next) S.a_ready(nxt);
            if constexpr (SP2) {
            PG8_LDB(B0, 0, 0); PG8_LDB(B1, 0, 1); PG8_SCHED; PG8_LDA(At, 0, 0); PG8_STAGE(PG8_SA(1, 1), a1 + hstepA, voffA);
            PG8_WAIT_V(8); PG8_WAIT_L(0); PG8_BAR; PG8_MMA(0, 0, At, B0); PG8_MMA(0, 1, At, B1); PG8_BAR; PG8_SCHED;
            PG8_LDA(At, 0, 1); PG8_STAGE(PG8_SB(0, 0), b2, voffB); PG8_STAGE(PG8_SB(0, 1), b2 + hstepB, voffB); PG8_STAGE(PG8_SA(0, 0), a2, voffA);
            PG8_WAIT_V(8); PG8_WAIT_L(0); PG8_BAR; PG8_MMA(1, 0, At, B0); PG8_MMA(1, 1, At, B1); PG8_BAR; PG8_SCHED;
            PG8_LDB(B0, 1, 0); PG8_LDB(B1, 1, 1); PG8_SCHED; PG8_LDA(At, 1, 0); PG8_STAGE(PG8_SA(0, 1), a2 + hstepA, voffA);
            PG8_WAIT_V(8); PG8_WAIT_L(0); PG8_BAR; PG8_MMA(0, 0, At, B0); PG8_MMA(0, 1, At, B1); PG8_BAR; PG8_SCHED;
            PG8_LDA(At, 1, 1); PG8_STAGE(PG8_SB(1, 0), b3, voffB); PG8_STAGE(PG8_SB(1, 1), b3 + hstepB, voffB); PG8_STAGE(PG8_SA(1, 0), a3, voffA);
            PG8_WAIT_V(8); PG8_WAIT_L(0); PG8_BAR; PG8_MMA(1, 0, At, B0); PG8_MMA(1, 1, At, B1); PG8_BAR; PG8_SCHED;
            } else {
            PG8_LDB(B0, 0, 0); PG8_SCHED; PG8_LDA(At, 0, 0); PG8_STAGE(PG8_SA(1, 1), a1 + hstepA, voffA);
            PG8_WAIT_L(8); PG8_BAR; PG8_WAIT_L(0); PG8_MMA(0, 0, At, B0); PG8_BAR; PG8_SCHED;
            PG8_LDB(B1, 0, 1); PG8_STAGE(PG8_SB(0, 0), b2, voffB);
            PG8_BAR; PG8_WAIT_L(0); PG8_MMA(0, 1, At, B1); PG8_BAR;
            PG8_LDA(At, 0, 1); PG8_STAGE(PG8_SA(0, 0), a2, voffA);
            PG8_BAR; PG8_WAIT_L(0); PG8_MMA(1, 0, At, B0); PG8_BAR; PG8_SCHED;
            PG8_STAGE(PG8_SB(0, 1), b2 + hstepB, voffB);
            PG8_WAIT_V(6); PG8_BAR; PG8_MMA(1, 1, At, B1); PG8_BAR;
            PG8_LDB(B0, 1, 0); PG8_SCHED; PG8_LDA(At, 1, 0); PG8_STAGE(PG8_SA(0, 1), a2 + hstepA, voffA);
            PG8_WAIT_L(8); PG8_BAR; PG8_WAIT_L(0); PG8_MMA(0, 0, At, B0); PG8_BAR; PG8_SCHED;
            PG8_LDB(B1, 1, 1); PG8_STAGE(PG8_SB(1, 0), b3, voffB);
            PG8_BAR; PG8_WAIT_L(0); PG8_MMA(0, 1, At, B1); PG8_BAR;
            PG8_LDA(At, 1, 1); PG8_STAGE(PG8_SA(1, 0), a3, voffA);
            PG8_BAR; PG8_WAIT_L(0); PG8_MMA(1, 0, At, B0); PG8_BAR; PG8_SCHED;
            PG8_STAGE(PG8_SB(1, 1), b3 + hstepB, voffB);
            PG8_WAIT_V(6); PG8_BAR; PG8_MMA(1, 1, At, B1); PG8_BAR;
            }
        }
        if constexpr (ALIGN_EPI) { if (wr == 0) PG8_BAR; }
        if constexpr (!Epi::AFTER_DRAIN) { E(acc, cur, wr, wc, fr, fq); S.done(cur); }
        if (!has_next) break;
#pragma unroll
        for (int a = 0; a < 2; ++a)
#pragma unroll
            for (int b = 0; b < 2; ++b)
#pragma unroll
                for (int m = 0; m < 4; ++m)
#pragma unroll
                    for (int n = 0; n < 2; ++n) acc[a][b][m][n] = (f32x4){0.f, 0.f, 0.f, 0.f};
        cur = nxt; cA = nA; cB = nB; ++ui;
        if constexpr (ALIGN_EPI) { if (wr == 1) PG8_BAR; }
    }
    PG8_WAIT_V(0);
    if constexpr (!ALIGN_EPI) { if (wr == 0) PG8_BAR; }
    PG8_BAR;
    if constexpr (Epi::AFTER_DRAIN) { E.fused(acc, cur, wr, wc, fr, fq, lds, wid, lane); S.done(cur); }
#undef PG8_SA
#undef PG8_SB
#undef PG8_STAGE
#undef PG8_LDA
#undef PG8_LDB
#undef PG8_MMA
#undef PG8_WAIT_V
#undef PG8_WAIT_L
#undef PG8_BAR
#undef PG8_SCHED
}
}

#define LAS __attribute__((address_space(3)))
#define DI __device__ __forceinline__
typedef unsigned short bf16_t;
typedef short bf16x8 __attribute__((ext_vector_type(8)));
typedef short s16x4 __attribute__((ext_vector_type(4)));
typedef float f32x4 __attribute__((ext_vector_type(4)));
typedef float f32x16 __attribute__((ext_vector_type(16)));
typedef unsigned u32x4 __attribute__((ext_vector_type(4)));
typedef unsigned u32x2 __attribute__((ext_vector_type(2)));
using pg8::cvtpk; using pg8::bf_lo; using pg8::bf_hi;

constexpr int BATCH = 32, SEQ = 2048, D = 1024, M = BATCH * SEQ, DFF = 2816;
constexpr int MXW = 5120;
constexpr int VTROWS = 1536;
constexpr int VTP = 65536 + 128;
constexpr float EPS = 1e-6f;
constexpr int C_RQ = 0, C_RK = 512, C_RG = 1024, C_NQ = 2048, C_NK = 2560, C_GR = 3072, C_GN = 4096;

constexpr size_t OFF_W_F1IN = 0;
constexpr size_t OFF_W_F1OUT = OFF_W_F1IN + (size_t)2 * DFF * D * 2;
constexpr size_t OFF_W_MIXM = OFF_W_F1OUT + (size_t)D * DFF * 2;
constexpr size_t OFF_W_VT = OFF_W_MIXM + (size_t)MXW * D * 2;
constexpr size_t OFF_W_RETO = OFF_W_VT + (size_t)VTROWS * D * 2;
constexpr size_t OFF_W_NAO = OFF_W_RETO + (size_t)D * D * 2;
constexpr size_t OFF_W_MIXO = OFF_W_NAO + (size_t)D * 512 * 2;
constexpr size_t OFF_W_F2IN = OFF_W_MIXO + (size_t)D * D * 2;
constexpr size_t OFF_W_F2OUT = OFF_W_F2IN + (size_t)2 * DFF * D * 2;
constexpr size_t OFF_COS = OFF_W_F2OUT + (size_t)D * DFF * 2;
constexpr size_t OFF_SIN = OFF_COS + (size_t)SEQ * 64 * 4;
constexpr size_t OFF_RS = OFF_SIN + (size_t)SEQ * 64 * 4;
constexpr size_t OFF_BAR = OFF_RS + 3 * (size_t)M * 4;
constexpr size_t OFF_XCNT = OFF_BAR + 16384;
constexpr size_t XCNT_BANK = 256 * 64 * 4;
constexpr size_t OFF_XBUF = OFF_XCNT + 6 * XCNT_BANK;
constexpr size_t OFF_XB = OFF_XBUF + 2 * (size_t)M * 4 * 4;
constexpr size_t OFF_BIG = OFF_XB + (size_t)M * D * 2;
constexpr size_t OFF_MX = OFF_BIG;
constexpr size_t OFF_VT = OFF_MX + (size_t)M * MXW * 2;
constexpr size_t OFF_H = OFF_BIG;
constexpr size_t OFF_HOUT = OFF_H + (size_t)M * DFF * 2;
constexpr size_t WS_END = OFF_VT + (size_t)VTROWS * VTP * 2;
static_assert(OFF_HOUT + (size_t)M * D * 2 <= WS_END && (size_t)M * D * 2 <= (size_t)VTROWS * VTP * 2, "workspace overlays");
static_assert(OFF_XB % 256 == 0 && OFF_VT % 256 == 0 && OFF_HOUT % 256 == 0, "alignment");

#ifndef RET_LOOPS
#define RET_LOOPS 1
#endif
#ifndef NA_LOOPS
#define NA_LOOPS 1
#endif
#ifndef EXTRA_SYNCS
#define EXTRA_SYNCS 0
#endif
#ifndef RET_DRY
#define RET_DRY 0
#endif
#ifndef NA_DRY
#define NA_DRY 0
#endif
#ifndef REP_MASK
#define REP_MASK 0
#endif
constexpr int GRID = 256;
constexpr int LDS_BYTES = 155648;

struct Params { const float* in[18]; float* out; unsigned char* ws; };

DI int lane_id() { int l; asm volatile("v_mbcnt_lo_u32_b32 %0, -1, 0\n\tv_mbcnt_hi_u32_b32 %0, -1, %0" : "=v"(l)); return l; }
constexpr int PTAB_OFF = LDS_BYTES - 16 - 192;
DI const float* PIN(LAS unsigned char* lds, int i) {
    int a = PTAB_OFF + 8 * i; asm volatile("" : "+v"(a));
    volatile LAS unsigned* t = (volatile LAS unsigned*)(lds + a);
    const unsigned lo = (unsigned)__builtin_amdgcn_readfirstlane((int)t[0]), hi = (unsigned)__builtin_amdgcn_readfirstlane((int)t[1]);
    return (const float*)(((unsigned long long)hi << 32) | lo);
}
#define POUT(lds) ((float*)PIN(lds, 18))
#define PWS(lds) ((unsigned char*)PIN(lds, 19))
DI float wave_sum(float v) {
#pragma unroll
    for (int o = 1; o < 64; o <<= 1) v += shx(v, o);
    return v;
}
DI unsigned f2bf(float f) { unsigned u = __builtin_bit_cast(unsigned, f); return (u + 0x7fffu + ((u >> 16) & 1u)) >> 16; }

__device__ const float c_rope_inv[64] = {1.000000000e+00f, 8.639885187e-01f, 7.464760542e-01f, 6.449466944e-01f, 5.572264791e-01f, 4.814372659e-01f, 4.159561992e-01f, 3.593813777e-01f, 3.105013072e-01f, 2.682695687e-01f, 2.317818254e-01f, 2.002568096e-01f, 1.730195731e-01f, 1.494869143e-01f, 1.291549653e-01f, 1.115884036e-01f, 9.641107917e-02f, 8.329805732e-02f, 7.196855545e-02f, 6.218000501e-02f, 5.372281000e-02f, 4.641588405e-02f, 4.010278732e-02f, 3.464834765e-02f, 2.993576974e-02f, 2.586415969e-02f, 2.234633639e-02f, 1.930697635e-02f, 1.668100618e-02f, 1.441219542e-02f, 1.245197095e-02f, 1.075835899e-02f, 9.295095690e-03f, 8.030855097e-03f, 6.938566454e-03f, 5.994840525e-03f, 5.179473199e-03f, 4.475005437e-03f, 3.866353072e-03f, 3.340484342e-03f, 2.886139555e-03f, 2.493591513e-03f, 2.154434333e-03f, 1.861406374e-03f, 1.608233666e-03f, 1.389495214e-03f, 1.200507861e-03f, 1.037224894e-03f, 8.961504791e-04f, 7.742635789e-04f, 6.689548027e-04f, 5.779692437e-04f, 4.993587499e-04f, 4.314401885e-04f, 3.727593285e-04f, 3.220597573e-04f, 2.782559313e-04f, 2.404098923e-04f, 2.077113895e-04f, 1.794602285e-04f, 1.550515735e-04f, 1.339627634e-04f, 1.157422957e-04f, 9.999999747e-05f};
DI void conv_item(const float* W, int K, int N, const float* gain, bf16_t* dst, int drow0, float scale, int k0, int n0, LAS float* scr, int lane) {
#pragma unroll 8
    for (int i = 0; i < 32; ++i) { const int kk = 2 * i + (lane >> 5); const float g = gain ? gain[k0 + kk] * scale : scale;
        scr[kk * 33 + (lane & 31)] = W[(size_t)(k0 + kk) * N + n0 + (lane & 31)] * g; }
    asm volatile("s_waitcnt lgkmcnt(0)" ::: "memory");
    const int c = lane & 7;
#pragma unroll
    for (int j = 0; j < 4; ++j) { const int n = (lane >> 3) + 8 * j; const LAS float* s = scr + (8 * c) * 33 + n;
        u32x4 o; o.x = cvtpk(s[0 * 33], s[1 * 33]); o.y = cvtpk(s[2 * 33], s[3 * 33]); o.z = cvtpk(s[4 * 33], s[5 * 33]); o.w = cvtpk(s[6 * 33], s[7 * 33]);
        *(u32x4*)(dst + (size_t)(drow0 + n) * K + k0 + 8 * c) = o; }
    asm volatile("s_waitcnt lgkmcnt(0)" ::: "memory");
}

DI void prologue(LAS unsigned char* lds, int G, const int wave_s) {
    int wave = wave_s; asm volatile("" : "+s"(wave));
    const int lane = lane_id(), tid = wave * 64 + lane;
    unsigned char* ws = PWS(lds);
    LAS float* scr = (LAS float*)(lds + wave * 16384);
    const int gw = blockIdx.x * 8 + wave, NGW = G * 8;
    constexpr int I0 = 16 * 176, I1 = 44 * 32, I2 = 16 * 208, I3 = 16 * 32, I4 = 8 * 32, I5 = 16 * 32;
    constexpr int NITEMS = 2 * (I0 + I1) + I2 + I3 + I4 + I5;
    for (int it = gw; it < NITEMS; it += NGW) {
        int r = it;
        const float* W; const float* gain = nullptr; bf16_t* dst; int K, N, drow0, k0, n0; float scale = 1.0f;
        int mid;
        if (r < I0) mid = 0; else { r -= I0;
        if (r < I1) mid = 1; else { r -= I1;
        if (r < I2) mid = 2; else { r -= I2;
        if (r < I3) mid = 3; else { r -= I3;
        if (r < I4) mid = 4; else { r -= I4;
        if (r < I5) mid = 5; else { r -= I5;
        if (r < I0) mid = 6; else { r -= I0; mid = 7; } } } } } } }
        if (mid == 0 || mid == 6) {
            W = PIN(lds, mid == 0 ? 2 : 15); gain = PIN(lds, mid == 0 ? 1 : 14); K = D; N = 2 * DFF;
            const int nblk = N / 32; k0 = 64 * (r / nblk); n0 = 32 * (r % nblk);
            const int half = n0 >= DFF ? 1 : 0, j = n0 - half * DFF;
            drow0 = 256 * (j >> 7) + 128 * half + (j & 127);
            dst = (bf16_t*)(ws + (mid == 0 ? OFF_W_F1IN : OFF_W_F2IN));
        } else if (mid == 1 || mid == 7) {
            W = PIN(lds, mid == 1 ? 3 : 16); K = DFF; N = D;
            const int nblk = N / 32; k0 = 64 * (r / nblk); n0 = 32 * (r % nblk); drow0 = n0;
            dst = (bf16_t*)(ws + (mid == 1 ? OFF_W_F1OUT : OFF_W_F2OUT));
        } else if (mid == 2) {
            W = PIN(lds, 6); gain = PIN(lds, 5); K = D; N = 6656;
            const int nblk = N / 32; k0 = 64 * (r / nblk); n0 = 32 * (r % nblk);
            dst = (bf16_t*)(ws + OFF_W_MIXM);
            if (n0 < 1024) { const int q = n0 & 511, hh = q >> 7, d = q & 127;
                drow0 = (n0 < 512 ? C_RQ : C_RK) + 256 * (hh >> 1) + 128 * (d >> 6) + 64 * (hh & 1) + (d & 63);
                if (n0 >= 512) scale = 0.08838834764831845f; }
            else if (n0 < 2048) { dst = (bf16_t*)(ws + OFF_W_VT); drow0 = n0 - 1024; }
            else if (n0 < 3072) { drow0 = C_RG + (n0 - 2048); }
            else if (n0 < 3584) { drow0 = C_NQ + (n0 - 3072); scale = 0.125f; }
            else if (n0 < 4096) { drow0 = C_NK + (n0 - 3584); }
            else if (n0 < 4608) { dst = (bf16_t*)(ws + OFF_W_VT); drow0 = 1024 + (n0 - 4096); }
            else if (n0 < 5632) { drow0 = C_GR + (n0 - 4608); }
            else { drow0 = C_GN + (n0 - 5632); }
        } else {
            W = PIN(lds, mid == 3 ? 10 : (mid == 4 ? 11 : 12)); K = (mid == 4) ? 512 : D; N = D;
            const int nblk = N / 32; k0 = 64 * (r / nblk); n0 = 32 * (r % nblk); drow0 = n0;
            dst = (bf16_t*)(ws + (mid == 3 ? OFF_W_RETO : (mid == 4 ? OFF_W_NAO : OFF_W_MIXO)));
        }
        conv_item(W, K, N, gain, dst, drow0, scale, k0, n0, scr, lane);
    }
    if (blockIdx.x == 0) { unsigned* bw = (unsigned*)(ws + OFF_BAR); for (int i = tid; i < 4096; i += 512) bw[i] = 0u; }
    { unsigned* xc = (unsigned*)(ws + OFF_XCNT); for (int i = blockIdx.x * 512 + tid; i < (int)(6 * XCNT_BANK / 4); i += G * 512) xc[i] = 0u; }
    float* cs = (float*)(ws + OFF_COS); float* sn = (float*)(ws + OFF_SIN);
    for (int idx = blockIdx.x * 512 + tid; idx < SEQ * 64; idx += G * 512) {
        const int pos = idx >> 6, i = idx & 63;
        const float inv = c_rope_inv[i];
        const float ang = (float)pos * inv;
        double rev = (double)ang * 0.15915494309189535; rev -= rint(rev);
        cs[idx] = __builtin_amdgcn_cosf((float)rev); sn[idx] = __builtin_amdgcn_sinf((float)rev);
    }
    const float* x = PIN(lds, 0); bf16_t* XB = (bf16_t*)(ws + OFF_XB); float* rs = (float*)(ws + OFF_RS);
    for (int row = gw; row < M; row += NGW) {
        const f32x4* xr = (const f32x4*)(x + (size_t)row * D) + lane;
        f32x4 v[4]; float ss = 0.f;
#pragma unroll
        for (int j = 0; j < 4; ++j) { v[j] = xr[64 * j]; ss += (v[j][0] * v[j][0] + v[j][1] * v[j][1]) + (v[j][2] * v[j][2] + v[j][3] * v[j][3]); }
        ss = wave_sum(ss);
        u32x2* o8 = (u32x2*)(XB + (size_t)row * D) + lane;
#pragma unroll
        for (int j = 0; j < 4; ++j) { u32x2 w; w.x = cvtpk(v[j][0], v[j][1]); w.y = cvtpk(v[j][2], v[j][3]); o8[64 * j] = w; }
        if (lane == 0) { rs[row] = ss; rs[M + row] = 0.f; rs[2 * M + row] = 0.f; }
    }
}

DI void elt_phase(const float* xold, const bf16_t* hb, const float* gpost, float cmul, float* xout, bf16_t* xb, float* rs, bool last, int G, const int wave_s) {
    int wave = wave_s; asm volatile("" : "+s"(wave));
    const int lane = lane_id(), tid = wave * 64 + lane;
    const int gw = blockIdx.x * 8 + wave, NGW = G * 8;
    f32x4 gp[4];
#pragma unroll
    for (int j = 0; j < 4; ++j) gp[j] = *((const f32x4*)gpost + lane + 64 * j) * cmul;
    for (int row = gw; row < M; row += NGW) {
        const u32x2* hp = (const u32x2*)(hb + (size_t)row * D) + lane;
        const f32x4* xr = (const f32x4*)(xold + (size_t)row * D) + lane;
        f32x4 h[4], xv[4]; float ss = 0.f;
#pragma unroll
        for (int j = 0; j < 4; ++j) { const u32x2 w = hp[64 * j]; xv[j] = xr[64 * j]; h[j] = (f32x4){bf_lo(w.x), bf_hi(w.x), bf_lo(w.y), bf_hi(w.y)};
            ss += (h[j][0] * h[j][0] + h[j][1] * h[j][1]) + (h[j][2] * h[j][2] + h[j][3] * h[j][3]); }
        const float nh = 1.0f / sqrtf(wave_sum(ss) * (1.0f / D) + EPS);
        float s2 = 0.f;
        f32x4* xo = (f32x4*)(xout + (size_t)row * D) + lane;
#pragma unroll
        for (int j = 0; j < 4; ++j) { xv[j] = xv[j] + gp[j] * h[j] * nh; xo[64 * j] = xv[j];
            s2 += (xv[j][0] * xv[j][0] + xv[j][1] * xv[j][1]) + (xv[j][2] * xv[j][2] + xv[j][3] * xv[j][3]); }
        if (!last) {
            s2 = wave_sum(s2);
            u32x2* o8 = (u32x2*)(xb + (size_t)row * D) + lane;
#pragma unroll
            for (int j = 0; j < 4; ++j) { u32x2 w; w.x = cvtpk(xv[j][0], xv[j][1]); w.y = cvtpk(xv[j][2], xv[j][3]); o8[64 * j] = w; }
            if (lane == 0) rs[row] = 1.0f / sqrtf(s2 * (1.0f / D) + EPS);
        }
    }
}

#define MFMA32(a, b, c) __builtin_amdgcn_mfma_f32_32x32x16_bf16((a), (b), (c), 0, 0, 0)
#define MFMA16(a, b, c) __builtin_amdgcn_mfma_f32_16x16x32_bf16((a), (b), (c), 0, 0, 0)
constexpr int RK_BYTES = 16384, RV_BYTES = 32768, RBUF = RK_BYTES + RV_BYTES;
constexpr int RTAB_OFF = 3 * RBUF;
static_assert(RTAB_OFF + 256 <= 155648 - 256, "mixer LDS");

DI bf16x8 ret_scale8(const bf16x8 v, const float w) {
    const u32x4 u = __builtin_bit_cast(u32x4, v); u32x4 o;
    o.x = cvtpk(bf_lo(u.x) * w, bf_hi(u.x) * w); o.y = cvtpk(bf_lo(u.y) * w, bf_hi(u.y) * w); o.z = cvtpk(bf_lo(u.z) * w, bf_hi(u.z) * w); o.w = cvtpk(bf_lo(u.w) * w, bf_hi(u.w) * w);
    return __builtin_bit_cast(bf16x8, o);
}
DI void ret_unit(LAS unsigned char* lds, bf16_t* MX, const bf16_t* VT, bf16_t* ST, int b, int hh, int qt, float lgf, float nlgb, int wave, const int mode) {
    const int qc = 256 * (hh >> 1) + 64 * (hh & 1);
    const size_t tok0 = (size_t)b * SEQ;
    const int q0w = qt * 256 + wave * 32;
    const int tid = wave * 64 + lane_id();
    const int lane = tid & 63, r = lane & 31, h = lane >> 5;
    int tq; bf16x8 qf[8];
    if (mode == 0) {
        tq = q0w + r;
        const bf16_t* qrow = MX + (tok0 + tq) * MXW + C_RQ + qc + 8 * h;
#pragma unroll
        for (int s = 0; s < 8; ++s) qf[s] = *(const bf16x8*)(qrow + (s >> 2) * 128 + (s & 3) * 16);
    } else {
        tq = (wave < 4) ? qt * 256 + 255 : qt * 256;
        const int target = 32 * (wave & 3) + r;
#pragma unroll
        for (int s = 0; s < 8; ++s) { const bool hit = ((target >> 4) == s) && (((target >> 3) & 1) == h); const int j = target & 7;
            u32x4 w; w.x = (hit && (j >> 1) == 0) ? ((j & 1) ? 0x3F800000u : 0x00003F80u) : 0u; w.y = (hit && (j >> 1) == 1) ? ((j & 1) ? 0x3F800000u : 0x00003F80u) : 0u;
            w.z = (hit && (j >> 1) == 2) ? ((j & 1) ? 0x3F800000u : 0x00003F80u) : 0u; w.w = (hit && (j >> 1) == 3) ? ((j & 1) ? 0x3F800000u : 0x00003F80u) : 0u;
            qf[s] = __builtin_bit_cast(bf16x8, w); }
    }
    const bf16_t* Kb = MX + tok0 * MXW + C_RK + qc;
    const bf16_t* Vb = VT + (size_t)(hh * 256) * VTP + tok0;
    const bf16_t* Sb = ST + ((size_t)((b * 4 + hh) * 8) << 16);
    const int kt0 = 4 * qt, NT = mode ? 4 : (4 + (qt > 0 ? 2 : 0) + (qt < 7 ? 2 : 0));
#define RET_ISSUE(t_, buf_) do { const int tt_ = (t_); const int ln_ = lane_id();     \
        const char* Kt_ = (const char*)Kb + (size_t)(kt0 + (tt_ < 4 ? tt_ : 0)) * (64 * MXW * 2); \
        _Pragma("unroll") for (int i_ = 0; i_ < 2; ++i_) { const int key_ = 4 * (wave * 2 + i_) + (ln_ >> 4), ck_ = (ln_ & 15) ^ (key_ & 15); \
            __builtin_amdgcn_global_load_lds((const unsigned*)(Kt_ + (unsigned)(key_ * MXW + (ck_ >> 3) * 128 + (ck_ & 7) * 8) * 2u), (LAS unsigned*)(lds + (buf_) * RBUF + (wave * 2 + i_) * 1024), 16, 0, 0); } \
        if (tt_ < 4) { const char* Vt_ = (const char*)Vb + (size_t)(kt0 + tt_) * 128; \
            _Pragma("unroll") for (int i_ = 0; i_ < 4; ++i_) { const int dv_ = 8 * (wave * 4 + i_) + (ln_ >> 3), c_ = (ln_ & 7) ^ ((dv_ >> 1) & 7); \
                __builtin_amdgcn_global_load_lds((const unsigned*)(Vt_ + (unsigned)(dv_ * VTP + c_ * 8) * 2u), (LAS unsigned*)(lds + (buf_) * RBUF + RK_BYTES + (wave * 4 + i_) * 1024), 16, 0, 0); } \
        } else { const int dr_ = (qt == 0) ? 1 : ((tt_ - 4) >> 1), pp_ = (tt_ - 4) & 1, nn_ = dr_ ? (qt < 7 ? qt + 1 : 7) : (qt > 0 ? qt - 1 : 0);     \
            const char* St_ = (const char*)(Sb + ((size_t)nn_ << 16) + dr_ * 128 + pp_ * 64); \
            _Pragma("unroll") for (int i_ = 0; i_ < 4; ++i_) { const int dv_ = 8 * (wave * 4 + i_) + (ln_ >> 3), c_ = (ln_ & 7) ^ ((dv_ >> 1) & 7); \
                __builtin_amdgcn_global_load_lds((const unsigned*)(St_ + (unsigned)(dv_ * 256 + c_ * 8) * 2u), (LAS unsigned*)(lds + (buf_) * RBUF + RK_BYTES + (wave * 4 + i_) * 1024), 16, 0, 0); } } } while (0)
    const int kA = r * 256 + 16 * (h ^ (r & 1)), sx32 = ((r & 15) >> 1) * 32;
    const int vA = r * 128, mv16 = (((r >> 1) & 7) * 16) ^ (h * 16);
    const LAS float* tab = (const LAS float*)(lds + RTAB_OFF);
    f32x16 z[8];
#pragma unroll
    for (int d = 0; d < 8; ++d)
#pragma unroll
        for (int i = 0; i < 16; ++i) z[d][i] = 0.f;
    RET_ISSUE(0, 0); RET_ISSUE(1, 1);
    int cur = 0, nx2 = 2;
#pragma unroll 1
    for (int t = 0; t < NT; ++t) {
        if (t + 1 < NT) asm volatile("s_waitcnt vmcnt(6)" ::: "memory");
        else asm volatile("s_waitcnt vmcnt(0)" ::: "memory");
        __builtin_amdgcn_s_barrier();
        asm volatile("" ::: "memory");
        if (t + 2 < NT) RET_ISSUE(t + 2, nx2);
        const LAS unsigned char* Kl = lds + cur * RBUF;
        const LAS unsigned char* Vl = Kl + RK_BYTES;
        bf16x8 f4[4];
        if (t < 4) {
            const int kt = kt0 + t;
            const bool fwd = (mode == 0) && (kt * 64 + 64 <= q0w), bwd = (mode == 0) && (kt * 64 >= q0w + 32);
#pragma unroll
            for (int kb = 0; kb < 2; ++kb) {
                f32x16 x;
#pragma unroll
                for (int i = 0; i < 16; ++i) x[i] = 0.f;
                { bf16x8 af[8];
#pragma unroll
                  for (int s = 0; s < 8; ++s) af[s] = *(const LAS bf16x8*)(Kl + kA + ((s * 32) ^ sx32) + kb * 8192);
#pragma unroll
                  for (int s = 0; s < 8; ++s) x = MFMA32(af[s], qf[s], x); }
                __builtin_amdgcn_sched_barrier(0);
                const float dq = (float)(tq - kt * 64 - 4 * h - 32 * kb);
                if (fwd || bwd) {
                    const float cf = fwd ? lgf : nlgb;
                    const float A0 = __builtin_amdgcn_exp2f(cf * dq);
                    const LAS f32x4* T = (const LAS f32x4*)(tab + (fwd ? 0 : 16));
                    const f32x4 c0 = T[0], c1 = T[1], c2 = T[2], c3 = T[3];
#pragma unroll
                    for (int e = 0; e < 4; ++e) { x[e] *= A0 * c0[e]; x[4 + e] *= A0 * c1[e]; x[8 + e] *= A0 * c2[e]; x[12 + e] *= A0 * c3[e]; }
                } else {
#pragma unroll
                    for (int i = 0; i < 16; ++i) { const float v0 = dq - (float)((i & 3) + 8 * (i >> 2)); x[i] *= __builtin_amdgcn_exp2f(fminf(lgf * v0, nlgb * v0)); }
                }
#pragma unroll
                for (int s2 = 0; s2 < 2; ++s2) {
                    u32x4 pw; pw.x = cvtpk(x[8 * s2 + 0], x[8 * s2 + 1]); pw.y = cvtpk(x[8 * s2 + 2], x[8 * s2 + 3]); pw.z = cvtpk(x[8 * s2 + 4], x[8 * s2 + 5]); pw.w = cvtpk(x[8 * s2 + 6], x[8 * s2 + 7]);
                    f4[2 * kb + s2] = __builtin_bit_cast(bf16x8, pw);
                }
                __builtin_amdgcn_sched_barrier(0);
            }
        } else {
            const int dr = (qt == 0) ? 1 : ((t - 4) >> 1), pp = (t - 4) & 1;
            const float wgt = dr ? (qt < 7 ? __builtin_amdgcn_exp2f(nlgb * (float)(tq - 256 * (qt + 1))) : 0.f) : (qt > 0 ? __builtin_amdgcn_exp2f(lgf * (float)(tq - 256 * qt + 1)) : 0.f);
#pragma unroll
            for (int f = 0; f < 4; ++f) {
                const unsigned msk = pp ? 0xffffffffu : 0u; const u32x4 lo4 = __builtin_bit_cast(u32x4, qf[f]), hi4 = __builtin_bit_cast(u32x4, qf[4 + f]);
                u32x4 sv; sv.x = (lo4.x & ~msk) | (hi4.x & msk); sv.y = (lo4.y & ~msk) | (hi4.y & msk); sv.z = (lo4.z & ~msk) | (hi4.z & msk); sv.w = (lo4.w & ~msk) | (hi4.w & msk);
                f4[f] = ret_scale8(__builtin_bit_cast(bf16x8, sv), wgt); }
            __builtin_amdgcn_sched_barrier(0);
        }
#pragma unroll
        for (int f = 0; f < 4; ++f) {
            const int vo = vA + ((f * 32) ^ mv16);
#pragma unroll
            for (int db = 0; db < 8; ++db) z[db] = MFMA32(f4[f], *(const LAS bf16x8*)(Vl + vo + db * 4096), z[db]);
            __builtin_amdgcn_sched_barrier(0);
        }
        cur = (cur == 2) ? 0 : cur + 1; nx2 = (nx2 == 2) ? 0 : nx2 + 1;
    }
#undef RET_ISSUE
    const int tide = lane_id();
    const int le = tide & 63, re = le & 31, he = le >> 5;
    if (mode != 0) {
        bf16_t* sp = ST + ((size_t)(((b * 4 + hh) * 8) + qt) << 16) + 32 * wave + 4 * he;
#pragma unroll
        for (int db = 0; db < 8; ++db)
#pragma unroll
            for (int g = 0; g < 4; ++g) { u32x2 w; w.x = cvtpk(z[db][4 * g + 0], z[db][4 * g + 1]); w.y = cvtpk(z[db][4 * g + 2], z[db][4 * g + 3]);
                *(u32x2*)(sp + (size_t)(db * 32 + re) * 256 + 8 * g) = w; }
        return;
    }
    f32x16 nrm;
#pragma unroll
    for (int i = 0; i < 16; ++i) {
        float ss = 0.f;
#pragma unroll
        for (int db = 0; db < 8; ++db) ss += z[db][i] * z[db][i];
        ss += shx(ss, 1); ss += shx(ss, 2); ss += shx(ss, 4); ss += shx(ss, 8); ss += shx(ss, 16);
        nrm[i] = 1.0f / sqrtf(ss * (1.0f / 256.0f) + EPS);
    }
    __syncthreads();
    LAS unsigned char* T = lds + wave * 8704;
#pragma unroll
    for (int hf = 0; hf < 2; ++hf) {
#pragma unroll
        for (int i = 0; i < 16; ++i) { const int q = (i & 3) + 8 * (i >> 2) + 4 * he;
#pragma unroll
            for (int d4 = 0; d4 < 4; ++d4) *(LAS bf16_t*)(T + q * 272 + (d4 * 32 + re) * 2) = (bf16_t)f2bf(z[hf * 4 + d4][i] * nrm[i]); }
        asm volatile("s_waitcnt lgkmcnt(0)" ::: "memory");
#pragma unroll
        for (int k = 0; k < 8; ++k) { const int id = le + 64 * k, q = id >> 4, ch = id & 15;
            const u32x4 ov = *(const LAS u32x4*)(T + q * 272 + ch * 16);
            bf16_t* gp = MX + (tok0 + q0w + q) * MXW + C_RG + hh * 256 + hf * 128 + ch * 8;
            const u32x4 gv = *(const u32x4*)gp;
            u32x4 w; w.x = cvtpk(bf_lo(ov.x) * bf_lo(gv.x), bf_hi(ov.x) * bf_hi(gv.x)); w.y = cvtpk(bf_lo(ov.y) * bf_lo(gv.y), bf_hi(ov.y) * bf_hi(gv.y));
            w.z = cvtpk(bf_lo(ov.z) * bf_lo(gv.z), bf_hi(ov.z) * bf_hi(gv.z)); w.w = cvtpk(bf_lo(ov.w) * bf_lo(gv.w), bf_hi(ov.w) * bf_hi(gv.w));
            *(u32x4*)gp = w; }
        asm volatile("s_waitcnt lgkmcnt(0)" ::: "memory");
    }
}

constexpr int NA_SLOT = 16384, NA_KROW = 8192;
constexpr int NA_RELB_OFF = 8 * NA_SLOT;
constexpr int NA_MRG_OFF = NA_RELB_OFF + 2048;
constexpr int NA_LDS_END = NA_MRG_OFF + 4 * 64 * 18 * 4;
static_assert(NA_LDS_END <= LDS_BYTES - 256, "NA LDS map");
DI void na_phase(LAS unsigned char* lds, int G, int vcu, const int wave_s, const bool do_store = true) {
    int wave = wave_s; asm volatile("" : "+s"(wave));
    const int lane = lane_id(), tid = wave * 64 + lane;
    const int fr = lane & 15, fq = lane >> 4, cb = wave & 3, kh = wave >> 2;
    bf16_t* MX = (bf16_t*)(PWS(lds) + OFF_MX); const bf16_t* VT = (const bf16_t*)(PWS(lds) + OFF_VT);
    unsigned koff, voff;
    { const int tok = 8 * wave + (lane >> 3), c = (lane & 7) ^ ((tok >> 1) & 7); koff = (unsigned)(tok * MXW + c * 8) * 2u; }
    { const int d = 8 * wave + (lane >> 3), c = (lane & 7) ^ (d & 7); voff = (unsigned)(d * VTP + c * 8) * 2u; }
    const int kc0 = min(max(16 * cb - 8, 0), 32);
    const int qcol = cb * 16 + fr, wst = min(max(qcol - 8, 0), 48);
    const LAS float* rb = (const LAS float*)(lds + NA_RELB_OFF);
#pragma unroll 1
    for (int bh = vcu; bh < BATCH * 8; bh += G) {
        const int b = bh >> 3, h = bh & 7;
        const char* Kbase = (const char*)(MX + (size_t)b * SEQ * MXW + C_NK + h * 64);
        const char* Vbase = (const char*)(VT + (size_t)(1024 + h * 64) * VTP + (size_t)b * SEQ);
#define NA_ISSUE_ROW(row_) do { const int rw_ = (row_); \
        __builtin_amdgcn_global_load_lds((const unsigned*)(Kbase + (size_t)rw_ * (64 * MXW * 2) + koff), (LAS unsigned*)(lds + (rw_ & 7) * NA_SLOT + wave * 1024), 16, 0, 0); \
        __builtin_amdgcn_global_load_lds((const unsigned*)(Vbase + (size_t)rw_ * 128 + voff), (LAS unsigned*)(lds + (rw_ & 7) * NA_SLOT + NA_KROW + wave * 1024), 16, 0, 0); } while (0)
        __syncthreads();
        if (tid < 465) ((LAS float*)(lds + NA_RELB_OFF))[tid] = PIN(lds, 9)[h * 465 + tid];
#pragma unroll
        for (int i = 0; i < 8; ++i) NA_ISSUE_ROW(i);
        asm volatile("s_waitcnt lgkmcnt(0)" ::: "memory"); __builtin_amdgcn_s_barrier(); asm volatile("" ::: "memory");
        f32x4 bm[8];
#pragma unroll
        for (int w = 0; w < 4; ++w)
#pragma unroll
            for (int cblk = 0; cblk < 2; ++cblk)
#pragma unroll
                for (int j = 0; j < 4; ++j) {
                    const int keycol = kc0 + cblk * 16 + 4 * fq + j;
                    const bool valid = (keycol >= wst) && (keycol < wst + 16);
                    const int cidx = min(max(keycol - qcol + 15, 0), 30);
                    bm[w * 2 + cblk][j] = valid ? rb[(4 * kh + w + 3) * 31 + cidx] : -1.0e30f;
                }
        float mrun = 0.f, lrun = 0.f; f32x4 ot[4]; bf16_t* outp = nullptr;
#pragma unroll
        for (int d = 0; d < 4; ++d) ot[d] = (f32x4){0.f, 0.f, 0.f, 0.f};
        bf16x8 qn0, qn1;
        { const bf16_t* qp = MX + ((size_t)b * SEQ + cb * 16 + fr) * MXW + C_NQ + h * 64 + 8 * fq; qn0 = *(const bf16x8*)qp; qn1 = *(const bf16x8*)(qp + 32); }
#pragma unroll 1
        for (int r = 0; r <= 32; ++r) {
            asm volatile("s_waitcnt vmcnt(0) lgkmcnt(0)" ::: "memory");
            __builtin_amdgcn_s_barrier();
            asm volatile("" ::: "memory");
            const int rs_ = min(max(r - 4, 0), 24);
            const bool has_new = (r >= 5 && r <= 28);
            if (has_new) NA_ISSUE_ROW(rs_ + 7);
            asm volatile("" ::: "memory");
            if (r > 0 && kh == 0) {
                const LAS float* mp = (const LAS float*)(lds + NA_MRG_OFF) + (cb * 64 + lane) * 18;
                const float m1 = mp[16], l1 = mp[17];
                const float mm = fmaxf(mrun, m1), a0 = __builtin_amdgcn_exp2f((mrun - mm) * 1.44269504f), a1 = __builtin_amdgcn_exp2f((m1 - mm) * 1.44269504f);
                float l0 = lrun; l0 += shx(l0, 16); l0 += shx(l0, 32);
                const float il = 1.0f / (l0 * a0 + l1 * a1);
#pragma unroll
                for (int db = 0; db < 4; ++db) { const f32x4 o1 = *(const LAS f32x4*)(mp + 4 * db); const f32x4 o = (ot[db] * a0 + o1 * a1) * il;
                    u32x2 w; w.x = cvtpk(o[0], o[1]); w.y = cvtpk(o[2], o[3]); if (do_store) *(u32x2*)(outp + db * 16) = w; }
            }
            if (r == 32) break;
            const size_t tokq = (size_t)b * SEQ + r * 64 + cb * 16 + fr;
            const bf16x8 qf0 = qn0, qf1 = qn1;
            outp = MX + tokq * MXW + C_NQ + h * 64 + 4 * fq;
            if (r + 1 < 32) { const bf16_t* qp = MX + (tokq + 64) * MXW + C_NQ + h * 64 + 8 * fq; qn0 = *(const bf16x8*)qp; qn1 = *(const bf16x8*)(qp + 32); }
            f32x4 st[6];
#pragma unroll
            for (int rowl = 0; rowl < 3; ++rowl) {
                const LAS unsigned char* Kl = lds + ((rs_ + 4 * kh + rowl) & 7) * NA_SLOT;
#pragma unroll
                for (int cblk = 0; cblk < 2; ++cblk) {
                    const int tok = kc0 + cblk * 16 + fr, sw = (tok >> 1) & 7;
                    const bf16x8 a0 = *(const LAS bf16x8*)(Kl + tok * 128 + ((fq ^ sw) * 16)), a1 = *(const LAS bf16x8*)(Kl + tok * 128 + (((4 + fq) ^ sw) * 16));
                    f32x4 c = {0.f, 0.f, 0.f, 0.f};
                    c = MFMA16(a0, qf0, c); c = MFMA16(a1, qf1, c); st[rowl * 2 + cblk] = c;
                }
            }
            float mloc = -3.0e38f;
            const bool interior = (r >= 4 && r <= 28);
            if (interior) {
#pragma unroll
                for (int i = 0; i < 6; ++i)
#pragma unroll
                    for (int j = 0; j < 4; ++j) { const float sv = st[i][j] + bm[i][j]; st[i][j] = sv; mloc = fmaxf(mloc, sv); }
            } else
#pragma unroll
            for (int rowl = 0; rowl < 3; ++rowl) {
                const int ridx = rs_ + 4 * kh + rowl - r + 7;
#pragma unroll
                for (int cblk = 0; cblk < 2; ++cblk)
#pragma unroll
                    for (int j = 0; j < 4; ++j) {
                        const int keycol = kc0 + cblk * 16 + 4 * fq + j;
                        const bool valid = (keycol >= wst) && (keycol < wst + 16);
                        const int cidx = min(max(keycol - qcol + 15, 0), 30);
                        const float sv = valid ? st[rowl * 2 + cblk][j] + rb[ridx * 31 + cidx] : -1.0e30f;
                        st[rowl * 2 + cblk][j] = sv; mloc = fmaxf(mloc, sv);
                    }
            }
            mloc = fmaxf(mloc, shx(mloc, 16)); mloc = fmaxf(mloc, shx(mloc, 32));
            mrun = mloc; lrun = 0.f;
#pragma unroll
            for (int d = 0; d < 4; ++d) ot[d] = (f32x4){0.f, 0.f, 0.f, 0.f};
#pragma unroll
            for (int i = 0; i < 6; ++i)
#pragma unroll
                for (int j = 0; j < 4; ++j) { const float pv = __builtin_amdgcn_exp2f((st[i][j] - mrun) * 1.44269504f); st[i][j] = pv; lrun += pv; }
            const int ch = (kc0 >> 3) + (fq >> 1);
#pragma unroll
            for (int rowl = 0; rowl < 3; ++rowl) {
                u32x4 pw; pw.x = cvtpk(st[rowl * 2][0], st[rowl * 2][1]); pw.y = cvtpk(st[rowl * 2][2], st[rowl * 2][3]); pw.z = cvtpk(st[rowl * 2 + 1][0], st[rowl * 2 + 1][1]); pw.w = cvtpk(st[rowl * 2 + 1][2], st[rowl * 2 + 1][3]);
                const bf16x8 pb = __builtin_bit_cast(bf16x8, pw);
                const LAS unsigned char* Vl = lds + ((rs_ + 4 * kh + rowl) & 7) * NA_SLOT + NA_KROW;
#pragma unroll
                for (int db = 0; db < 4; ++db) {
                    const LAS unsigned char* vrow = Vl + (db * 16 + fr) * 128 + (fq & 1) * 8;
                    const s16x4 lo = *(const LAS s16x4*)(vrow + ((ch ^ (fr & 7)) * 16)), hi = *(const LAS s16x4*)(vrow + (((ch + 2) ^ (fr & 7)) * 16));
                    ot[db] = MFMA16(__builtin_shufflevector(lo, hi, 0, 1, 2, 3, 4, 5, 6, 7), pb, ot[db]);
                }
            }
            if (r + 1 < 32) asm volatile("s_waitcnt vmcnt(2)" ::: "memory"); else asm volatile("s_waitcnt vmcnt(0)" ::: "memory");
            __builtin_amdgcn_s_barrier();
            asm volatile("" ::: "memory");
            {
                const int rowa = rs_ + 4 * kh + 3;
                const LAS unsigned char* Kl = lds + (rowa & 7) * NA_SLOT;
                f32x4 s2[2];
#pragma unroll
                for (int cblk = 0; cblk < 2; ++cblk) {
                    const int tok = kc0 + cblk * 16 + fr, sw = (tok >> 1) & 7;
                    const bf16x8 a0 = *(const LAS bf16x8*)(Kl + tok * 128 + ((fq ^ sw) * 16)), a1 = *(const LAS bf16x8*)(Kl + tok * 128 + (((4 + fq) ^ sw) * 16));
                    f32x4 c = {0.f, 0.f, 0.f, 0.f};
                    c = MFMA16(a0, qf0, c); c = MFMA16(a1, qf1, c); s2[cblk] = c;
                }
                const int ridx = rowa - r + 7;
                float ml2 = -3.0e38f;
                if (interior) {
#pragma unroll
                    for (int cblk = 0; cblk < 2; ++cblk)
#pragma unroll
                        for (int j = 0; j < 4; ++j) { const float sv = s2[cblk][j] + bm[6 + cblk][j]; s2[cblk][j] = sv; ml2 = fmaxf(ml2, sv); }
                } else
#pragma unroll
                for (int cblk = 0; cblk < 2; ++cblk)
#pragma unroll
                    for (int j = 0; j < 4; ++j) {
                        const int keycol = kc0 + cblk * 16 + 4 * fq + j;
                        const bool valid = (keycol >= wst) && (keycol < wst + 16);
                        const int cidx = min(max(keycol - qcol + 15, 0), 30);
                        const float sv = valid ? s2[cblk][j] + rb[ridx * 31 + cidx] : -1.0e30f;
                        s2[cblk][j] = sv; ml2 = fmaxf(ml2, sv);
                    }
                ml2 = fmaxf(ml2, shx(ml2, 16)); ml2 = fmaxf(ml2, shx(ml2, 32));
                const float mn = fmaxf(mrun, ml2), sc = __builtin_amdgcn_exp2f((mrun - mn) * 1.44269504f); mrun = mn; lrun *= sc;
#pragma unroll
                for (int d = 0; d < 4; ++d) ot[d] = ot[d] * sc;
#pragma unroll
                for (int cblk = 0; cblk < 2; ++cblk)
#pragma unroll
                    for (int j = 0; j < 4; ++j) { const float pv = __builtin_amdgcn_exp2f((s2[cblk][j] - mrun) * 1.44269504f); s2[cblk][j] = pv; lrun += pv; }
                u32x4 pw; pw.x = cvtpk(s2[0][0], s2[0][1]); pw.y = cvtpk(s2[0][2], s2[0][3]); pw.z = cvtpk(s2[1][0], s2[1][1]); pw.w = cvtpk(s2[1][2], s2[1][3]);
                const bf16x8 pb = __builtin_bit_cast(bf16x8, pw);
                const LAS unsigned char* Vl = Kl + NA_KROW;
#pragma unroll
                for (int db = 0; db < 4; ++db) {
                    const LAS unsigned char* vrow = Vl + (db * 16 + fr) * 128 + (fq & 1) * 8;
                    const s16x4 lo = *(const LAS s16x4*)(vrow + ((ch ^ (fr & 7)) * 16)), hi = *(const LAS s16x4*)(vrow + (((ch + 2) ^ (fr & 7)) * 16));
                    ot[db] = MFMA16(__builtin_shufflevector(lo, hi, 0, 1, 2, 3, 4, 5, 6, 7), pb, ot[db]);
                }
            }
            if (kh == 1) {
                LAS float* mp = (LAS float*)(lds + NA_MRG_OFF) + (cb * 64 + lane) * 18;
                float l1 = lrun; l1 += shx(l1, 16); l1 += shx(l1, 32);
#pragma unroll
                for (int db = 0; db < 4; ++db) *(LAS f32x4*)(mp + 4 * db) = ot[db];
                mp[16] = mrun; mp[17] = l1;
            }
        }
#undef NA_ISSUE_ROW
    }
}

DI void ret_state_sweep(LAS unsigned char* lds, const bf16_t* MX, const bf16_t* VT, bf16_t* ST, int b, int hh, int dir, float lg, int wave) {
    const int qc = 256 * (hh >> 1) + 64 * (hh & 1);
    const size_t tok0 = (size_t)b * SEQ;
    const int lane = lane_id(), r = lane & 31, h = lane >> 5;
    const int dkg = wave & 3, dvh = wave >> 2;
    bf16x8 qf[8];
    { const int target = 32 * dkg + r;
#pragma unroll
      for (int s = 0; s < 8; ++s) { const bool hit = ((target >> 4) == s) && (((target >> 3) & 1) == h); const int j = target & 7;
        u32x4 w; w.x = (hit && (j >> 1) == 0) ? ((j & 1) ? 0x3F800000u : 0x00003F80u) : 0u; w.y = (hit && (j >> 1) == 1) ? ((j & 1) ? 0x3F800000u : 0x00003F80u) : 0u;
        w.z = (hit && (j >> 1) == 2) ? ((j & 1) ? 0x3F800000u : 0x00003F80u) : 0u; w.w = (hit && (j >> 1) == 3) ? ((j & 1) ? 0x3F800000u : 0x00003F80u) : 0u;
        qf[s] = __builtin_bit_cast(bf16x8, w); } }
    const bf16_t* Kb = MX + tok0 * MXW + C_RK + qc;
    const bf16_t* Vb = VT + (size_t)(hh * 256) * VTP + tok0;
#define SW_KT(i_) (4 * (dir ? 7 - ((i_) >> 2) : ((i_) >> 2)) + ((i_) & 3))
#define SW_ISSUE(i_, buf_) do { const int kt_ = SW_KT(i_); const int ln_ = lane_id(); \
        const char* Kt_ = (const char*)Kb + (size_t)kt_ * (64 * MXW * 2); const char* Vt_ = (const char*)Vb + (size_t)kt_ * 128; \
        _Pragma("unroll") for (int i2_ = 0; i2_ < 2; ++i2_) { const int key_ = 4 * (wave * 2 + i2_) + (ln_ >> 4), ck_ = (ln_ & 15) ^ (key_ & 15); \
            __builtin_amdgcn_global_load_lds((const unsigned*)(Kt_ + (unsigned)(key_ * MXW + (ck_ >> 3) * 128 + (ck_ & 7) * 8) * 2u), (LAS unsigned*)(lds + (buf_) * RBUF + (wave * 2 + i2_) * 1024), 16, 0, 0); } \
        _Pragma("unroll") for (int i2_ = 0; i2_ < 4; ++i2_) { const int dv_ = 8 * (wave * 4 + i2_) + (ln_ >> 3), c_ = (ln_ & 7) ^ ((dv_ >> 1) & 7); \
            __builtin_amdgcn_global_load_lds((const unsigned*)(Vt_ + (unsigned)(dv_ * VTP + c_ * 8) * 2u), (LAS unsigned*)(lds + (buf_) * RBUF + RK_BYTES + (wave * 4 + i2_) * 1024), 16, 0, 0); } } while (0)
    const int kA = r * 256 + 16 * (h ^ (r & 1)), sx32 = ((r & 15) >> 1) * 32;
    const int vA = r * 128 + dvh * (4 * 4096), mv16 = (((r >> 1) & 7) * 16) ^ (h * 16);
    const float g256 = __builtin_amdgcn_exp2f(lg * 256.0f);
    f32x16 z[4], R[4];
#pragma unroll
    for (int d = 0; d < 4; ++d)
#pragma unroll
        for (int i = 0; i < 16; ++i) { z[d][i] = 0.f; R[d][i] = 0.f; }
    SW_ISSUE(0, 0); SW_ISSUE(1, 1);
    int cur = 0, nx2 = 2;
#pragma unroll 1
    for (int it = 0; it < 28; ++it) {
        if (it + 1 < 28) asm volatile("s_waitcnt vmcnt(6)" ::: "memory");
        else asm volatile("s_waitcnt vmcnt(0)" ::: "memory");
        __builtin_amdgcn_s_barrier();
        asm volatile("" ::: "memory");
        if (it + 2 < 28) SW_ISSUE(it + 2, nx2);
        const LAS unsigned char* Kl = lds + cur * RBUF;
        const LAS unsigned char* Vl = Kl + RK_BYTES;
        const int kt = SW_KT(it), n = kt >> 2;
        const int tqf = dir ? 256 * n : 256 * n + 255;
        bf16x8 f4[4];
#pragma unroll
        for (int kb = 0; kb < 2; ++kb) {
            f32x16 x;
#pragma unroll
            for (int i = 0; i < 16; ++i) x[i] = 0.f;
            { bf16x8 af[8];
#pragma unroll
              for (int s = 0; s < 8; ++s) af[s] = *(const LAS bf16x8*)(Kl + kA + ((s * 32) ^ sx32) + kb * 8192);
#pragma unroll
              for (int s = 0; s < 8; ++s) x = MFMA32(af[s], qf[s], x); }
            __builtin_amdgcn_sched_barrier(0);
            const float d0 = dir ? (float)(kt * 64 + kb * 32 + 4 * h - tqf) : (float)(tqf - kt * 64 - kb * 32 - 4 * h);
#pragma unroll
            for (int i = 0; i < 16; ++i) { const float cr = (float)((i & 3) + 8 * (i >> 2)); x[i] *= __builtin_amdgcn_exp2f(lg * (dir ? d0 + cr : d0 - cr)); }
#pragma unroll
            for (int s2 = 0; s2 < 2; ++s2) {
                u32x4 pw; pw.x = cvtpk(x[8 * s2 + 0], x[8 * s2 + 1]); pw.y = cvtpk(x[8 * s2 + 2], x[8 * s2 + 3]); pw.z = cvtpk(x[8 * s2 + 4], x[8 * s2 + 5]); pw.w = cvtpk(x[8 * s2 + 6], x[8 * s2 + 7]);
                f4[2 * kb + s2] = __builtin_bit_cast(bf16x8, pw);
            }
            __builtin_amdgcn_sched_barrier(0);
        }
#pragma unroll
        for (int f = 0; f < 4; ++f) {
            const int vo = vA + ((f * 32) ^ mv16);
#pragma unroll
            for (int db = 0; db < 4; ++db) z[db] = MFMA32(f4[f], *(const LAS bf16x8*)(Vl + vo + db * 4096), z[db]);
            __builtin_amdgcn_sched_barrier(0);
        }
        if ((it & 3) == 3) {
            bf16_t* sp = ST + ((size_t)(((b * 4 + hh) * 8) + n) << 16) + (size_t)(dvh * 128 + r) * 256 + dir * 128 + 32 * dkg + 4 * h;
#pragma unroll
            for (int db = 0; db < 4; ++db) {
#pragma unroll
                for (int i = 0; i < 16; ++i) { R[db][i] = R[db][i] * g256 + z[db][i]; z[db][i] = 0.f; }
#pragma unroll
                for (int g = 0; g < 4; ++g) { u32x2 w; w.x = cvtpk(R[db][4 * g + 0], R[db][4 * g + 1]); w.y = cvtpk(R[db][4 * g + 2], R[db][4 * g + 3]);
                    *(u32x2*)(sp + (size_t)(db * 32) * 256 + 8 * g) = w; }
            }
        }
        cur = (cur == 2) ? 0 : cur + 1; nx2 = (nx2 == 2) ? 0 : nx2 + 1;
    }
#undef SW_ISSUE
#undef SW_KT
}
DI void mixer_states(LAS unsigned char* lds, int G, const int wave_s) {
    int wave = wave_s; asm volatile("" : "+s"(wave));
    bf16_t* MX = (bf16_t*)(PWS(lds) + OFF_MX); const bf16_t* VT = (const bf16_t*)(PWS(lds) + OFF_VT); bf16_t* ST = (bf16_t*)POUT(lds);
    const int vcu = (G % 8 == 0) ? (int)(blockIdx.x & 7) * (G / 8) + (int)(blockIdx.x >> 3) : (int)blockIdx.x;
    for (int u = vcu; u < BATCH * 4 * 2; u += G) {
        const int dir = u & 1, hh = (u >> 1) & 3, b = u >> 3;
        const float lg = -log1pf(__expf(-PIN(lds, dir ? 8 : 7)[hh])) * 1.44269504f;
        __syncthreads();
        ret_state_sweep(lds, MX, VT, ST, b, hh, dir, lg, wave);
    }
}
DI void mixer_phase(LAS unsigned char* lds, int G, const int wave_s) {
    int wave = wave_s; asm volatile("" : "+s"(wave));
    const int lane = lane_id(), tid = wave * 64 + lane;
    bf16_t* MX = (bf16_t*)(PWS(lds) + OFF_MX); const bf16_t* VT = (const bf16_t*)(PWS(lds) + OFF_VT); bf16_t* ST = (bf16_t*)POUT(lds);
    const int vcu = (G % 8 == 0) ? (int)(blockIdx.x & 7) * (G / 8) + (int)(blockIdx.x >> 3) : (int)blockIdx.x;
    for (int u = vcu; u < BATCH * 4 * 8; u += G) {
        const int qt = u & 7, hh = (u >> 3) & 3, b = u >> 5;
        const float ef = __expf(-PIN(lds, 7)[hh]), eb = __expf(-PIN(lds, 8)[hh]);
        const float lgf = -log1pf(ef) * 1.44269504f, nlgb = log1pf(eb) * 1.44269504f;
        __syncthreads();
        { const int t2 = wave * 64 + lane_id();
          if (t2 < 32) { const int i = t2 & 15; const float cr = (float)((i & 3) + 8 * (i >> 2));
            ((LAS float*)(lds + RTAB_OFF))[t2] = __builtin_amdgcn_exp2f(-(t2 < 16 ? lgf : nlgb) * cr); } }
        __syncthreads();
        ret_unit(lds, MX, VT, ST, b, hh, qt, lgf, nlgb, wave, 0);
    }
    __syncthreads();
    na_phase(lds, G, vcu, wave_s);
}

#define XB_TMO      128
#define XB_XCNT(j)  (256  + 64 * (j))
#define XB_XSUB(j)  (1280 + 64 * (j))
#define XB_XGEN(j)  (2304 + 64 * (j))
#define XB_TOP      3328
#define XB_TOPGEN   3392
#define XCD_BAR_WORDS 3456
#define XB_SPIN_CAP (1u << 18)

__device__ __forceinline__ unsigned xb_ld(unsigned* p)              { return __hip_atomic_load(p, __ATOMIC_RELAXED, __HIP_MEMORY_SCOPE_AGENT); }
__device__ __forceinline__ unsigned xb_add(unsigned* p, unsigned v) { return __hip_atomic_fetch_add(p, v, __ATOMIC_RELAXED, __HIP_MEMORY_SCOPE_AGENT); }
__device__ __forceinline__ unsigned xb_xcc_id() { return (unsigned)__builtin_amdgcn_s_getreg((3 << 11) | 20) & 0xFu; }
#define XB_SPIN(cond, bar) do { unsigned _sp = 0; while (cond) { __builtin_amdgcn_s_sleep(1); \
    if ((++_sp & 255u) == 0u) { if (xb_ld(&(bar)[XB_TMO])) break; if (_sp > XB_SPIN_CAP) { atomicAdd(&(bar)[XB_TMO], 1u); break; } } } } while (0)

struct XcdBarrier {
    unsigned* bar; unsigned x;
    volatile LAS unsigned* st;
};

__device__ __forceinline__ XcdBarrier xcd_barrier_post(unsigned* bar, volatile LAS unsigned* st, const bool t0) {
    XcdBarrier b; b.bar = bar; b.x = xb_xcc_id(); b.st = st;
    if (t0) (void)xb_add(&bar[XB_XCNT(b.x)], 1u);
    return b;
}
__device__ __forceinline__ void xcd_barrier_complete(unsigned* bar, unsigned x, unsigned& nloc, unsigned& nx) {
    const unsigned G = gridDim.x * gridDim.y * gridDim.z;
    unsigned sum, cnt, mine, sp = 0u;
    for (;;) {
        sum = 0u; cnt = 0u; mine = 0u;
#pragma unroll
        for (unsigned j = 0; j < 16; ++j) { const unsigned c = xb_ld(&bar[XB_XCNT(j)]); sum += c; cnt += (c > 0u) ? 1u : 0u; mine = (j == x) ? c : mine; }
        if (sum == G) break;
        __builtin_amdgcn_s_sleep(1);
        if ((++sp & 255u) == 0u) { if (xb_ld(&bar[XB_TMO])) break; if (sp > XB_SPIN_CAP) { atomicAdd(&bar[XB_TMO], 1u); break; } }
    }
    nloc = mine > 0u ? mine : 1u; nx = cnt > 0u ? cnt : 1u;
}

__device__ __forceinline__ void xcd_barrier(const XcdBarrier& b, const bool t0) {
    asm volatile("s_waitcnt vmcnt(0)" ::: "memory");
    __syncthreads();
    if (t0) {
        unsigned* bar = b.bar;
        __builtin_amdgcn_s_waitcnt(0);
        unsigned nloc = b.st[0], nx = b.st[1];
        if (nloc == 0u) { xcd_barrier_complete(bar, b.x, nloc, nx); b.st[0] = nloc; b.st[1] = nx; }
        const unsigned old = xb_add(&bar[XB_XSUB(b.x)], 1u);
        const unsigned gen = old / nloc;
        if (old + 1u == (gen + 1u) * nloc) {
            __builtin_amdgcn_fence(__ATOMIC_RELEASE, "agent");
            asm volatile("s_waitcnt vmcnt(0)" ::: "memory");
            const unsigned og = xb_add(&bar[XB_TOP], 1u);
            const unsigned tg = og / nx;
            if (og + 1u == (tg + 1u) * nx) xb_add(&bar[XB_TOPGEN], 1u);
            else XB_SPIN(xb_ld(&bar[XB_TOPGEN]) == tg, bar);
            __builtin_amdgcn_fence(__ATOMIC_ACQUIRE, "agent");
            xb_add(&bar[XB_XGEN(b.x)], 1u);
            asm volatile("s_waitcnt vmcnt(0)" ::: "memory");
        } else {
            XB_SPIN(xb_ld(&bar[XB_XGEN(b.x)]) == gen, bar);
            __builtin_amdgcn_fence(__ATOMIC_ACQUIRE, "agent");
            asm volatile("s_waitcnt vmcnt(0)" ::: "memory");
        }
    }
    __syncthreads();
}

__global__ void __launch_bounds__(512) mega(Params p) {
    extern __shared__ __attribute__((aligned(16))) unsigned char lds_raw[];
    LAS unsigned char* lds = (LAS unsigned char*)lds_raw;
    cg::grid_group grid = cg::this_grid();
    constexpr int G = GRID;
    const int wave_s = __builtin_amdgcn_readfirstlane((int)threadIdx.x >> 6);
    if (threadIdx.x == 0) { volatile LAS unsigned long long* pt = (volatile LAS unsigned long long*)(lds + PTAB_OFF);
        pt[0] = (unsigned long long)p.in[0]; pt[1] = (unsigned long long)p.in[1]; pt[2] = (unsigned long long)p.in[2]; pt[3] = (unsigned long long)p.in[3]; pt[4] = (unsigned long long)p.in[4]; pt[5] = (unsigned long long)p.in[5];
        pt[6] = (unsigned long long)p.in[6]; pt[7] = (unsigned long long)p.in[7]; pt[8] = (unsigned long long)p.in[8]; pt[9] = (unsigned long long)p.in[9]; pt[10] = (unsigned long long)p.in[10]; pt[11] = (unsigned long long)p.in[11];
        pt[12] = (unsigned long long)p.in[12]; pt[13] = (unsigned long long)p.in[13]; pt[14] = (unsigned long long)p.in[14]; pt[15] = (unsigned long long)p.in[15]; pt[16] = (unsigned long long)p.in[16]; pt[17] = (unsigned long long)p.in[17];
        pt[18] = (unsigned long long)p.out; pt[19] = (unsigned long long)p.ws; }
    volatile LAS unsigned* bst = (volatile LAS unsigned*)(lds + LDS_BYTES - 16);
    if (threadIdx.x < 2) bst[threadIdx.x] = 0u;
    __syncthreads();
    XcdBarrier xbar; xbar.bar = nullptr; xbar.x = 0; xbar.st = bst;
#pragma unroll 1
    for (int step = 0; step < 13; ++step) {
        const int ph = (step <= 4) ? step : (step == 5 ? 50 : step - 1);
        unsigned char* ws = PWS(lds);
        bf16_t* XB = (bf16_t*)(ws + OFF_XB); bf16_t* MX = (bf16_t*)(ws + OFF_MX); bf16_t* VT = (bf16_t*)(ws + OFF_VT);
        bf16_t* HB = (bf16_t*)(ws + OFF_H); bf16_t* HOUT = (bf16_t*)(ws + OFF_HOUT);
        float* rs = (float*)(ws + OFF_RS);
#if REP_MASK
      for (int rep = 0; rep <= ((REP_MASK >> ph) & 1); ++rep) {
#endif
        if (ph == 0) {
            prologue(lds, G, wave_s);
        } else if (ph == 3 || ph == 8 || ph == 11) {
            continue;
        } else if (ph == 2 || ph == 7 || ph == 10) {
            pg8::Gemm g; pg8::EpiRes E;
            const int fz = (ph == 2) ? 0 : (ph == 7 ? 1 : 2);
            if (ph == 7) g = pg8::Gemm{VT, (const bf16_t*)(ws + OFF_W_MIXO), D, D, M, D, D};
            else g = pg8::Gemm{HB, (const bf16_t*)(ws + (ph == 2 ? OFF_W_F1OUT : OFF_W_F2OUT)), DFF, DFF, M, D, DFF};
            E.xin32 = nullptr;   E.xinb = XB; E.xout = POUT(lds); E.gpost = PIN(lds, ph == 2 ? 4 : (ph == 7 ? 13 : 17)); E.halfstep = (ph == 7) ? 0 : 1;
            E.xb = XB; E.ssn = rs + (size_t)(fz + 1) * M; E.last = (ph == 10) ? 1 : 0; E.xl = lds + 131072;
            E.st1.xbuf = (unsigned*)(ws + OFF_XBUF); E.st1.cnt = (unsigned*)(ws + OFF_XCNT + (size_t)fz * XCNT_BANK);
            pg8::StaticOrder SO; SO.init(M, D, G, (int)blockIdx.x);
            SO.rev = (ph != 7) ? 1 : 0;
            pg8::gemm_phase<pg8::EpiRes, pg8::StaticOrder, true, true>(lds, g, SO, E, wave_s);
        } else if (ph == 50) {
            mixer_states(lds, G, wave_s);
        } else if (ph == 5) {
            mixer_phase(lds, G, wave_s);
        } else {
            const int njobs = (ph == 4 || ph == 6) ? 2 : 1;
#pragma unroll 1
            for (int j = 0; j < njobs; ++j) {
                pg8::Gemm g; pg8::Epi E; E.rs = rs + (size_t)(ph == 1 ? 0 : (ph == 4 ? 1 : 2)) * M; E.cs = (const float*)(ws + OFF_COS); E.sn = (const float*)(ws + OFF_SIN); E.gate = nullptr; E.ldg = MXW;
                if (ph == 1 || ph == 9) { g = pg8::Gemm{XB, (const bf16_t*)(ws + (ph == 1 ? OFF_W_F1IN : OFF_W_F2IN)), D, D, M, 2 * DFF, D}; E.mode = pg8::M_SWIGLU; E.O = HB; E.ldc = DFF; }
                else if (ph == 2 || ph == 10) { g = pg8::Gemm{HB, (const bf16_t*)(ws + (ph == 2 ? OFF_W_F1OUT : OFF_W_F2OUT)), DFF, DFF, M, D, DFF}; E.mode = pg8::M_STORE; E.O = HOUT; E.ldc = D; }
                else if (ph == 4) {
                    if (j == 0) { g = pg8::Gemm{XB, (const bf16_t*)(ws + OFF_W_MIXM), D, D, M, MXW, D}; E.mode = pg8::M_MIX; E.O = MX; E.ldc = MXW; }
                    else { g = pg8::Gemm{(const bf16_t*)(ws + OFF_W_VT), XB, D, D, VTROWS, M, D}; E.mode = pg8::M_VT; E.O = VT; E.ldc = VTP; }
                } else if (ph == 6) {
                    if (j == 0) { g = pg8::Gemm{MX + C_RG, (const bf16_t*)(ws + OFF_W_RETO), MXW, D, M, D, D}; E.mode = pg8::M_RETOUT; E.O = VT; E.ldc = D; E.gate = MX + C_GR; }
                    else { g = pg8::Gemm{MX + C_NQ, (const bf16_t*)(ws + OFF_W_NAO), MXW, 512, M, D, 512}; E.mode = pg8::M_NAOUT; E.O = VT; E.ldc = D; E.gate = MX + C_GN; }
                } else { g = pg8::Gemm{XB, (const bf16_t*)(ws + OFF_W_MIXO), D, D, M, D, D}; E.mode = pg8::M_STORE; E.O = VT; E.ldc = D; }
                pg8::StaticOrder S; S.init(g.M, g.N, G, (int)blockIdx.x);
                pg8::gemm_phase<pg8::Epi, pg8::StaticOrder, true, true>(lds, g, S, E, wave_s);
            }
        }
        if (ph == 0) { grid.sync(); xbar = xcd_barrier_post((unsigned*)(ws + OFF_BAR), bst, wave_s == 0 && lane_id() == 0); }
        else if (ph < 10 || ph >= 50) xcd_barrier(xbar, wave_s == 0 && lane_id() == 0);
#if EXTRA_SYNCS
        if (ph == 0) { for (int e = 0; e < EXTRA_SYNCS; ++e) xcd_barrier(xbar, wave_s == 0 && lane_id() == 0); }
#endif
#if REP_MASK
      }
#endif
    }
}

extern "C" void kernel_launch(void* const* d_in, const int* in_sizes, int n_in, void* d_out, int out_size, void* d_ws, size_t ws_size, hipStream_t stream) {
    static int grid = 0;
    if (grid == 0) {
        if (n_in != 18 || out_size != M * D || ws_size < WS_END) { fprintf(stderr, "kernel_launch: unexpected problem (n_in %d out %d ws %zu, need %zu)\n", n_in, out_size, ws_size, (size_t)WS_END); grid = -1; return; }
        int dev = 0, cus = 0, per_cu = 0;
        if (hipGetDevice(&dev) != hipSuccess || hipDeviceGetAttribute(&cus, hipDeviceAttributeMultiprocessorCount, dev) != hipSuccess) { grid = -1; return; }
        if (hipFuncSetAttribute((const void*)mega, hipFuncAttributeMaxDynamicSharedMemorySize, LDS_BYTES) != hipSuccess) { fprintf(stderr, "kernel_launch: hipFuncSetAttribute failed\n"); grid = -1; return; }
        if (hipOccupancyMaxActiveBlocksPerMultiprocessor(&per_cu, (const void*)mega, 512, LDS_BYTES) != hipSuccess || per_cu < 1) { fprintf(stderr, "kernel_launch: occupancy query says %d\n", per_cu); (void)hipGetLastError(); }
        if (cus < GRID) { fprintf(stderr, "kernel_launch: built for a %d-CU device, found %d CUs; nothing launched\n", GRID, cus); grid = -1; return; }
        grid = GRID;
    }
    if (grid < 0) return;
    Params p{};
    for (int i = 0; i < 18; ++i) p.in[i] = (const float*)d_in[i];
    p.out = (float*)d_out; p.ws = (unsigned char*)d_ws;
    void* args[] = {&p};
    hipError_t e = hipLaunchCooperativeKernel((const void*)mega, dim3(grid), dim3(512), args, LDS_BYTES, stream);
    if (e != hipSuccess) fprintf(stderr, "cooperative launch failed: %s (grid %d)\n", hipGetErrorString(e), grid);
}
```
